# Optimizing an MI355X kernel written in HIP

```python
import math
import jax, jax.numpy as jnp
from jax import lax
import numpy as np

D_MODEL = 1024
BATCH = 4
SEQ = 4096
DEPTH = 1

N_MEM = 256
HA = 8
DA = 64
A_WIDTH = HA * 2 * DA
Q_BLOCK = 128
NUM_BUCKETS = 32
MAX_DISTANCE = 128
HB = 8
KB = 128
VB = 128
B_WIDTH = HB * VB
CHUNK = 64
HC = 4
DC = 256
C_WIDTH = HC * DC
N_BRANCH = 3
IN_SIZES = (
    2 * HA * DA, 2 * HA * DA, A_WIDTH, A_WIDTH,
    HB * KB, HB * KB, HB * KB, B_WIDTH, B_WIDTH,
    C_WIDTH, C_WIDTH,
    N_BRANCH * D_MODEL,
)
IN_COLS = sum(IN_SIZES)
EPS = 1e-6

kernel_name = "hybrid_diffattn_hgrn2_memxattn_block"


def rmsnorm(x, w):
    xf = x.astype(jnp.float32)
    y = xf * lax.rsqrt(jnp.mean(xf * xf, axis=-1, keepdims=True) + EPS)
    return (y * w.astype(jnp.float32)).astype(x.dtype)


def t5_bucket(rel):
    nb = NUM_BUCKETS // 2
    max_exact = nb // 2
    ret = jnp.where(rel > 0, nb, 0)
    n = jnp.abs(rel)
    nf = jnp.maximum(n, 1).astype(jnp.float32)
    large = max_exact + (jnp.log(nf / max_exact) / math.log(MAX_DISTANCE / max_exact)
                         * (nb - max_exact)).astype(jnp.int32)
    large = jnp.minimum(large, nb - 1)
    return ret + jnp.where(n < max_exact, n, large)


def diff_attention(q, k, v, lam, rel_bias):
    B, L = q.shape[0], q.shape[1]
    nblk = L // Q_BLOCK
    qb = q.reshape(B, nblk, Q_BLOCK, 2, HA, DA).transpose(1, 0, 3, 4, 2, 5)
    kt = k.transpose(0, 2, 3, 1, 4)
    vt = v.transpose(0, 2, 1, 3)
    kpos = jnp.arange(L, dtype=jnp.int32)
    scale = DA ** -0.5

    def block(args):
        qblk, start = args
        qpos = start + jnp.arange(Q_BLOCK, dtype=jnp.int32)
        bucket = t5_bucket(kpos[None, :] - qpos[:, None])
        bias = jnp.transpose(rel_bias[bucket], (2, 0, 1)).astype(jnp.float32)
        s = jnp.einsum('bmhqd,bmhkd->bmhqk', qblk, kt).astype(jnp.float32) * scale + bias
        p = jax.nn.softmax(s, axis=-1)
        w = p[:, 0] - lam * p[:, 1]
        return jnp.einsum('bhqk,bhkv->bhqv', w.astype(vt.dtype), vt)

    starts = jnp.arange(nblk, dtype=jnp.int32) * Q_BLOCK
    out = lax.map(block, (qb, starts))
    return out.transpose(1, 0, 3, 2, 4).reshape(B, L, HA, 2 * DA)


def gla_chunk(q, k, v, g):
    B, H, L, K = q.shape
    V = v.shape[-1]
    N = L // CHUNK
    qc = q.reshape(B, H, N, CHUNK, K).astype(jnp.float32)
    kc = k.reshape(B, H, N, CHUNK, K).astype(jnp.float32)
    vc = v.reshape(B, H, N, CHUNK, V).astype(jnp.float32)
    gc = g.reshape(B, H, N, CHUNK, K).astype(jnp.float32)
    b = jnp.cumsum(gc, axis=3)
    b_mid = b[:, :, :, CHUNK // 2 - 1:CHUNK // 2, :]
    b_last = b[:, :, :, CHUNK - 1:, :]
    a = jnp.einsum('bhnck,bhnsk->bhncs', qc * jnp.exp(b - b_mid), kc * jnp.exp(b_mid - b))
    mask = jnp.arange(CHUNK)[None, :] <= jnp.arange(CHUNK)[:, None]
    a = jnp.where(mask, a, 0.0)
    o_intra = jnp.einsum('bhncs,bhnsv->bhncv', a, vc)
    u = jnp.einsum('bhnsk,bhnsv->bhnkv', kc * jnp.exp(b_last - b), vc)
    decay = jnp.exp(b_last[:, :, :, 0, :])

    def step(s, inp):
        d, un = inp
        return d[..., None] * s + un, s

    s0 = jnp.zeros((B, H, K, V), jnp.float32)
    _, s_prev = lax.scan(step, s0, (jnp.moveaxis(decay, 2, 0), jnp.moveaxis(u, 2, 0)))
    s_prev = jnp.moveaxis(s_prev, 0, 2)
    o_inter = jnp.einsum('bhnck,bhnkv->bhncv', qc * jnp.exp(b), s_prev)
    return (o_intra + o_inter).reshape(B, H, L, V)


def hgrn2_gates(f_logit, lb):
    f32 = f_logit.astype(jnp.float32)
    g = jnp.log(lb + (1.0 - lb) * jax.nn.sigmoid(f32))
    kk = (1.0 - lb) * jax.nn.sigmoid(-f32)
    return g, kk


def to_heads(t, h, d):
    B, L = t.shape[0], t.shape[1]
    return t.reshape(B, L, h, d).transpose(0, 2, 1, 3)


def split_columns(p):
    idx = []
    acc = 0
    for s in IN_SIZES[:-1]:
        acc += s
        idx.append(acc)
    return jnp.split(p, idx, axis=-1)


def setup_inputs(seed: int = 0) -> dict:
    key = jax.random.key(seed)
    ks = jax.random.split(key, 20)
    f32 = jnp.float32
    nrm = lambda k, shape, s: (jax.random.normal(k, shape, f32) * s)
    return {
        "x": nrm(ks[0], (BATCH, SEQ, D_MODEL), 1.0),
        "mem": nrm(ks[1], (BATCH, N_MEM, D_MODEL), 1.0),
        "pre_norm": 1.0 + nrm(ks[2], (DEPTH, D_MODEL), 0.02),
        "post_norm": 1.0 + nrm(ks[3], (DEPTH, D_MODEL), 0.02),
        "w_in": nrm(ks[4], (DEPTH, D_MODEL, IN_COLS), D_MODEL ** -0.5),
        "lambda_q1": nrm(ks[5], (DEPTH, DA), 0.1),
        "lambda_k1": nrm(ks[6], (DEPTH, DA), 0.1),
        "lambda_q2": nrm(ks[7], (DEPTH, DA), 0.1),
        "lambda_k2": nrm(ks[8], (DEPTH, DA), 0.1),
        "diff_subln": 1.0 + nrm(ks[9], (DEPTH, 2 * DA), 0.02),
        "rel_bias": nrm(ks[10], (NUM_BUCKETS, HA), 0.5),
        "lb_logits": nrm(ks[11], (2, DEPTH + 1, HB * KB), 0.1),
        "hgrn_norm": 1.0 + nrm(ks[12], (DEPTH, VB), 0.02),
        "mem_norm": 1.0 + nrm(ks[13], (DEPTH, D_MODEL), 0.02),
        "w_mem_kv": nrm(ks[14], (DEPTH, D_MODEL, 2 * C_WIDTH), D_MODEL ** -0.5),
        "w_branch": nrm(ks[15], (DEPTH, N_BRANCH, A_WIDTH, D_MODEL), A_WIDTH ** -0.5),
        "w_out": nrm(ks[16], (DEPTH, D_MODEL, D_MODEL), D_MODEL ** -0.5),
    }


def reference(x, mem, pre_norm, post_norm, w_in, lambda_q1, lambda_k1, lambda_q2, lambda_k2,
              diff_subln, rel_bias, lb_logits, hgrn_norm, mem_norm, w_mem_kv, w_branch, w_out):
    B, L, _ = x.shape
    lb_all = jnp.cumsum(jax.nn.softmax(lb_logits.astype(jnp.float32), axis=1), axis=1)
    for l in range(DEPTH):
        h = rmsnorm(x, pre_norm[l])
        proj = h @ w_in[l]
        aq, ak, av, az, bq, bff, bfb, bi, bz, cq, cz, gates = split_columns(proj)

        lam_init = 0.8 - 0.6 * math.exp(-0.3 * l)
        lam = (jnp.exp(jnp.sum(lambda_q1[l].astype(jnp.float32) * lambda_k1[l].astype(jnp.float32)))
               - jnp.exp(jnp.sum(lambda_q2[l].astype(jnp.float32) * lambda_k2[l].astype(jnp.float32)))
               + lam_init)
        oa = diff_attention(aq.reshape(B, L, 2, HA, DA), ak.reshape(B, L, 2, HA, DA),
                            av.reshape(B, L, HA, 2 * DA), lam, rel_bias)
        oa = rmsnorm(oa, diff_subln[l]) * (1.0 - lam_init)
        ya = (oa.reshape(B, L, A_WIDTH) * jax.nn.silu(az)) @ w_branch[l, 0]

        g_f, k_f = hgrn2_gates(bff, lb_all[0, l])
        g_b, k_b = hgrn2_gates(bfb, lb_all[1, l])
        qh = to_heads(bq, HB, KB)
        vh = to_heads(bi, HB, VB)
        o_fwd = gla_chunk(qh, to_heads(k_f, HB, KB), vh, to_heads(g_f, HB, KB))
        flip = lambda t: jnp.flip(t, axis=2)
        o_bwd = flip(gla_chunk(flip(qh), flip(to_heads(k_b, HB, KB)), flip(vh),
                               flip(to_heads(g_b, HB, KB))))
        ob = (o_fwd + o_bwd).transpose(0, 2, 1, 3)
        ob = rmsnorm(ob, hgrn_norm[l]).astype(x.dtype)
        yb = (ob.reshape(B, L, B_WIDTH) * jax.nn.silu(bz)) @ w_branch[l, 1]

        m = rmsnorm(mem, mem_norm[l])
        mk, mv = jnp.split(m @ w_mem_kv[l], 2, axis=-1)
        mk = mk.reshape(B, N_MEM, HC, DC)
        mv = mv.reshape(B, N_MEM, HC, DC)
        s = jnp.einsum('blhd,bmhd->bhlm', cq.reshape(B, L, HC, DC), mk).astype(jnp.float32) * (DC ** -0.5)
        p = jax.nn.softmax(s, axis=-1).astype(mv.dtype)
        oc = jnp.einsum('bhlm,bmhd->blhd', p, mv).reshape(B, L, C_WIDTH)
        yc = (oc * jax.nn.silu(cz)) @ w_branch[l, 2]

        ga, gb, gc = jnp.split(jax.nn.sigmoid(gates), N_BRANCH, axis=-1)
        y = (ga * ya + gb * yb + gc * yc) @ w_out[l]
        x = x + rmsnorm(y, post_norm[l])
    return x
```

```cpp
#include <hip/hip_runtime.h>
#include <hip/hip_cooperative_groups.h>
#include <cstdio>
#include <cstdint>
namespace cg = cooperative_groups;
namespace pg8 {
#define PG8_LAS __attribute__((address_space(3)))
typedef unsigned short bf16_t;
typedef short bf16x8 __attribute__((ext_vector_type(8)));
typedef float f32x4 __attribute__((ext_vector_type(4)));
typedef unsigned u32x4 __attribute__((ext_vector_type(4)));
constexpr int BM = 256, BK = 64, HALF = 128, HTB = HALF * BK * 2, STAGE_BYTES = 8 * HTB, NXCD = 8, WGM = 8;

__host__ __device__ __forceinline__ int lds_byte(int r, int c) { const int st = (r >> 4) * 2 + (c >> 5), rr = r & 15, cc = c & 31, ob = rr * 64 + cc * 2; return st * 1024 + (ob ^ (((ob >> 9) & 1) << 5)); }
__host__ __device__ __forceinline__ void stage_rc(int b, int& R, int& C) { const int st = b / 1024, sb = b % 1024, swz = sb ^ (((sb >> 9) & 1) << 5); R = (st >> 1) * 16 + swz / 64; C = (st & 1) * 32 + (swz % 64) / 2; }
__host__ __device__ __forceinline__ int perm32(int rho) { const int n = rho >> 4, i = rho & 15; return 8 * (i >> 2) + 4 * n + (i & 3); }

struct Unit { int pm, pn; };
struct Gemm { const bf16_t* A; const bf16_t* Bt; int M, N, K, lda, ldb; };

struct StaticOrder {
    int nM, nN, nwg, G, c;
    __host__ __device__ void init(int M, int N, int G_, int c_) { nM = M / BM; nN = N / BM; nwg = nM * nN; G = G_; c = c_; }
    __host__ __device__ bool next(int i, Unit& u) const {
        const long L = (long)i * G + c; if (L >= nwg) return false;
        int wgid = (int)L; { const int q = nwg / NXCD, r = nwg % NXCD, xcd = wgid % NXCD, off = wgid / NXCD; wgid = (xcd < r ? xcd * (q + 1) : r * (q + 1) + (xcd - r) * q) + off; }
        const int nig = WGM * nN, gid = wgid / nig, fm = gid * WGM, gsz = (nM - fm) < WGM ? (nM - fm) : WGM;
        u.pm = fm + ((wgid % nig) % gsz); u.pn = (wgid % nig) / gsz; return true;
    }
    __device__ __forceinline__ void a_ready(const Unit&) const {}
    __device__ __forceinline__ void done(const Unit&) const {}
};

typedef float f32x2_t __attribute__((ext_vector_type(2))); typedef __bf16 bf16x2_t __attribute__((ext_vector_type(2)));
__device__ __forceinline__ unsigned cvt_pk_bf16(float lo, float hi) { f32x2_t v = {lo, hi}; bf16x2_t b = __builtin_convertvector(v, bf16x2_t); return __builtin_bit_cast(unsigned, b); }
__device__ __forceinline__ float bf_lo(unsigned w) { return __uint_as_float(w << 16); }
__device__ __forceinline__ float bf_hi(unsigned w) { return __uint_as_float(w & 0xffff0000u); }
__device__ __forceinline__ float fsigmoid(float v) { return __builtin_amdgcn_rcpf(1.0f + __builtin_amdgcn_exp2f(-1.4426950408889634f * v)); }

template <int MODE> struct EpiRoute {
    static constexpr bool PERM = true, AFTER_DRAIN = false;
    bf16_t *b0, *b1, *b2, *b3, *b4; int l0, l1, l2, l3, l4; int c0, c1, c2, c3, c4; float s0, s1, s2, s3, s4;
    __device__ __forceinline__ void operator()(const f32x4 (&acc)[2][2][4][2], const Unit& u, int wr, int wc, int fr, int fq) const {
        const int row0 = u.pm * BM + wr * 64 + fr; const int colt = u.pn * BM; const int g = colt >> 10, cw = colt & 1023;
        bf16_t* base = g == 0 ? b0 : g == 1 ? b1 : g == 2 ? b2 : g == 3 ? b3 : b4;
        const int ldc = g == 0 ? l0 : g == 1 ? l1 : g == 2 ? l2 : g == 3 ? l3 : l4;
        const int cof = g == 0 ? c0 : g == 1 ? c1 : g == 2 ? c2 : g == 3 ? c3 : c4;
        const float sc = g == 0 ? s0 : g == 1 ? s1 : g == 2 ? s2 : g == 3 ? s3 : s4;
        const int col0 = cof + cw + wc * 32 + 8 * fq;
#pragma unroll
        for (int ai = 0; ai < 2; ++ai)
#pragma unroll
            for (int m = 0; m < 4; ++m) { bf16_t* rowp = base + (size_t)(row0 + ai * HALF + m * 16) * ldc + col0;
#pragma unroll
                for (int bj = 0; bj < 2; ++bj) { f32x4 v0 = acc[ai][bj][m][0], v1 = acc[ai][bj][m][1];
                    if (MODE == 0) { v0 = v0 * sc; v1 = v1 * sc; }
                    if (MODE == 1) { const u32x4 o = *(const u32x4*)(rowp + bj * HALF);
#pragma unroll
                        for (int e = 0; e < 4; ++e) { v0[e] = v0[e] * fsigmoid(v0[e]); v1[e] = v1[e] * fsigmoid(v1[e]); }
                        v0[0] *= bf_lo(o.x); v0[1] *= bf_hi(o.x); v0[2] *= bf_lo(o.y); v0[3] *= bf_hi(o.y);
                        v1[0] *= bf_lo(o.z); v1[1] *= bf_hi(o.z); v1[2] *= bf_lo(o.w); v1[3] *= bf_hi(o.w); }
                    if (MODE == 2) {
#pragma unroll
                        for (int e = 0; e < 4; ++e) { v0[e] = fsigmoid(v0[e]); v1[e] = fsigmoid(v1[e]); } }
                    u32x4 w; w.x = cvt_pk_bf16(v0[0], v0[1]); w.y = cvt_pk_bf16(v0[2], v0[3]); w.z = cvt_pk_bf16(v1[0], v1[1]); w.w = cvt_pk_bf16(v1[2], v1[3]);
                    *(u32x4*)(rowp + bj * HALF) = w; } }
    }
};
template <bool FIRST> struct EpiBranch {
    static constexpr bool PERM = true, AFTER_DRAIN = false;
    const bf16_t* gate; bf16_t* mg; int ldg, ldc;
    __device__ __forceinline__ void operator()(const f32x4 (&acc)[2][2][4][2], const Unit& u, int wr, int wc, int fr, int fq) const {
        const int row0 = u.pm * BM + wr * 64 + fr; const int col0 = u.pn * BM + wc * 32 + 8 * fq;
#pragma unroll
        for (int ai = 0; ai < 2; ++ai)
#pragma unroll
            for (int m = 0; m < 4; ++m) { const size_t r = (size_t)(row0 + ai * HALF + m * 16);
#pragma unroll
                for (int bj = 0; bj < 2; ++bj) { f32x4 v0 = acc[ai][bj][m][0], v1 = acc[ai][bj][m][1];
                    const u32x4 g = *(const u32x4*)(gate + r * ldg + col0 + bj * HALF);
                    v0[0] *= bf_lo(g.x); v0[1] *= bf_hi(g.x); v0[2] *= bf_lo(g.y); v0[3] *= bf_hi(g.y);
                    v1[0] *= bf_lo(g.z); v1[1] *= bf_hi(g.z); v1[2] *= bf_lo(g.w); v1[3] *= bf_hi(g.w);
                    bf16_t* p = mg + r * ldc + col0 + bj * HALF;
                    if (!FIRST) { const u32x4 o = *(const u32x4*)p;
                        v0[0] += bf_lo(o.x); v0[1] += bf_hi(o.x); v0[2] += bf_lo(o.y); v0[3] += bf_hi(o.y);
                        v1[0] += bf_lo(o.z); v1[1] += bf_hi(o.z); v1[2] += bf_lo(o.w); v1[3] += bf_hi(o.w); }
                    u32x4 w; w.x = cvt_pk_bf16(v0[0], v0[1]); w.y = cvt_pk_bf16(v0[2], v0[3]); w.z = cvt_pk_bf16(v1[0], v1[1]); w.w = cvt_pk_bf16(v1[2], v1[3]);
                    *(u32x4*)p = w; } }
    }
};
struct EpiF32 {
    static constexpr bool PERM = false, AFTER_DRAIN = false;
    float* out; int ldc;
    __device__ __forceinline__ void operator()(const f32x4 (&acc)[2][2][4][2], const Unit& u, int wr, int wc, int fr, int fq) const {
        const int col0 = u.pn * BM + wc * 32 + 4 * fq;
#pragma unroll
        for (int ai = 0; ai < 2; ++ai)
#pragma unroll
            for (int m = 0; m < 4; ++m) { const size_t off = (size_t)(u.pm * BM + ai * HALF + wr * 64 + m * 16 + fr) * ldc + col0;
#pragma unroll
                for (int bj = 0; bj < 2; ++bj)
#pragma unroll
                    for (int n = 0; n < 2; ++n) *(f32x4*)(out + off + bj * HALF + n * 16) = acc[ai][bj][m][n]; }
    }
};

template <class Epi, class Sched, bool ALIGN_EPI>
__device__ __forceinline__ void gemm_phase(PG8_LAS unsigned char* lds, const Gemm g, const Sched& S, const Epi& E) {
    const int tid = threadIdx.x, wid = __builtin_amdgcn_readfirstlane(tid >> 6), lane = tid & 63, wr = wid >> 2, wc = wid & 3, fr = lane & 15, fq = lane >> 4;
    const int K = g.K, nt = K / BK;
    unsigned voffA[2], voffB[2];
#pragma unroll
    for (int i = 0; i < 2; ++i) { int R, C; stage_rc(tid * 16 + i * 8192, R, C); const int Rb = Epi::PERM ? ((R & ~31) + perm32(R & 31)) : R;
        voffA[i] = (unsigned)(R * g.lda + C) * 2u; voffB[i] = (unsigned)(Rb * g.ldb + C) * 2u; }
    const size_t kstep = (size_t)(BK * 2);
    const size_t hstepA = (size_t)HALF * g.lda * 2, hstepB = (size_t)HALF * g.ldb * 2;
    const size_t tstepA = 2 * hstepA, tstepB = 2 * hstepB;
    const unsigned ldsw = (unsigned)wid * 1024u;
    const int aoff = lds_byte(wr * 64 + fr, fq * 8), boff = lds_byte(wc * 32 + fr, fq * 8);
#define PG8_SA(b, h) (((b) * 2 + (h)) * HTB)
#define PG8_SB(b, h) ((4 + (b) * 2 + (h)) * HTB)
#define PG8_STAGE(bufoff, gbase, voff) do { _Pragma("unroll") for (int _i = 0; _i < 2; ++_i) \
        __builtin_amdgcn_global_load_lds((const unsigned*)((const char*)(gbase) + (voff)[_i]), (PG8_LAS unsigned*)(lds + (bufoff) + ldsw + _i * 8192), 16, 0, 0); } while (0)
#define PG8_LDA(dst, b, h) do { _Pragma("unroll") for (int m = 0; m < 4; ++m) _Pragma("unroll") for (int k = 0; k < 2; ++k) dst[m][k] = *(const PG8_LAS bf16x8*)(lds + PG8_SA(b, h) + aoff + m * 2048 + k * 1024); } while (0)
#define PG8_LDB(dst, b, h) do { _Pragma("unroll") for (int n = 0; n < 2; ++n) _Pragma("unroll") for (int k = 0; k < 2; ++k) dst[n][k] = *(const PG8_LAS bf16x8*)(lds + PG8_SB(b, h) + boff + n * 2048 + k * 1024); } while (0)
#define PG8_MMA(ai, bj, At, Bt) do { __builtin_amdgcn_s_setprio(1); _Pragma("unroll") for (int m = 0; m < 4; ++m) _Pragma("unroll") for (int n = 0; n < 2; ++n) _Pragma("unroll") for (int k = 0; k < 2; ++k) \
        acc[ai][bj][m][n] = __builtin_amdgcn_mfma_f32_16x16x32_bf16(Bt[n][k], At[m][k], acc[ai][bj][m][n], 0, 0, 0); __builtin_amdgcn_s_setprio(0); } while (0)
#define PG8_WAIT_V(n) asm volatile("s_waitcnt vmcnt(" #n ")" ::: "memory")
#define PG8_WAIT_L(n) asm volatile("s_waitcnt lgkmcnt(" #n ")" ::: "memory")
#define PG8_BAR __builtin_amdgcn_s_barrier()
#define PG8_SCHED __builtin_amdgcn_sched_barrier(0)
    Unit cur, nxt; int ui = 0;
    if (!S.next(0, cur)) return;
    f32x4 acc[2][2][4][2];
#pragma unroll
    for (int a = 0; a < 2; ++a)
#pragma unroll
        for (int b = 0; b < 2; ++b)
#pragma unroll
            for (int m = 0; m < 4; ++m)
#pragma unroll
                for (int n = 0; n < 2; ++n) acc[a][b][m][n] = (f32x4){0.f, 0.f, 0.f, 0.f};
    bf16x8 At[4][2], B0[2][2], B1[2][2];
    const char* cA = (const char*)g.A + (size_t)cur.pm * tstepA; const char* cB = (const char*)g.Bt + (size_t)cur.pn * tstepB;
    S.a_ready(cur);
    PG8_STAGE(PG8_SB(0, 0), cB, voffB); PG8_STAGE(PG8_SB(0, 1), cB + hstepB, voffB); PG8_STAGE(PG8_SA(0, 0), cA, voffA); PG8_STAGE(PG8_SA(0, 1), cA + hstepA, voffA);
    if (wr == 1) PG8_BAR;
    PG8_WAIT_V(2); PG8_BAR;
    PG8_STAGE(PG8_SB(1, 0), cB + kstep, voffB); PG8_STAGE(PG8_SA(1, 0), cA + kstep, voffA); PG8_STAGE(PG8_SB(1, 1), cB + hstepB + kstep, voffB);
    PG8_WAIT_V(6); PG8_BAR;
    for (;;) {
        const bool has_next = S.next(ui + 1, nxt);
        const char* nA = has_next ? (const char*)g.A + (size_t)nxt.pm * tstepA : cA; const char* nB = has_next ? (const char*)g.Bt + (size_t)nxt.pn * tstepB : cB;
        for (int t = 0; t < nt; t += 2) {
            const bool last = (t == nt - 2);
            const char* a1 = cA + (size_t)(t + 1) * kstep;
            const char* a2 = last ? nA : cA + (size_t)(t + 2) * kstep; const char* b2 = last ? nB : cB + (size_t)(t + 2) * kstep;
            const char* a3 = a2 + kstep; const char* b3 = b2 + kstep;
            if (last && has_next) S.a_ready(nxt);
            PG8_LDB(B0, 0, 0); PG8_LDB(B1, 0, 1); PG8_SCHED; PG8_LDA(At, 0, 0); PG8_STAGE(PG8_SA(1, 1), a1 + hstepA, voffA);
            PG8_WAIT_V(8); PG8_WAIT_L(0); PG8_BAR; PG8_MMA(0, 0, At, B0); PG8_MMA(0, 1, At, B1); PG8_BAR; PG8_SCHED;
            PG8_LDA(At, 0, 1); PG8_STAGE(PG8_SB(0, 0), b2, voffB); PG8_STAGE(PG8_SB(0, 1), b2 + hstepB, voffB); PG8_STAGE(PG8_SA(0, 0), a2, voffA);
            PG8_WAIT_V(8); PG8_WAIT_L(0); PG8_BAR; PG8_MMA(1, 0, At, B0); PG8_MMA(1, 1, At, B1); PG8_BAR; PG8_SCHED;
            PG8_LDB(B0, 1, 0); PG8_LDB(B1, 1, 1); PG8_SCHED; PG8_LDA(At, 1, 0); PG8_STAGE(PG8_SA(0, 1), a2 + hstepA, voffA);
            PG8_WAIT_V(8); PG8_WAIT_L(0); PG8_BAR; PG8_MMA(0, 0, At, B0); PG8_MMA(0, 1, At, B1); PG8_BAR; PG8_SCHED;
            PG8_LDA(At, 1, 1); PG8_STAGE(PG8_SB(1, 0), b3, voffB); PG8_STAGE(PG8_SB(1, 1), b3 + hstepB, voffB); PG8_STAGE(PG8_SA(1, 0), a3, voffA);
            PG8_WAIT_V(8); PG8_WAIT_L(0); PG8_BAR; PG8_MMA(1, 0, At, B0); PG8_MMA(1, 1, At, B1); PG8_BAR; PG8_SCHED;
        }
        if constexpr (ALIGN_EPI) { if (wr == 0) PG8_BAR; }
        E(acc, cur, wr, wc, fr, fq); S.done(cur);
        if (!has_next) break;
#pragma unroll
        for (int a = 0; a < 2; ++a)
#pragma unroll
            for (int b = 0; b < 2; ++b)
#pragma unroll
                for (int m = 0; m < 4; ++m)
#pragma unroll
                    for (int n = 0; n < 2; ++n) acc[a][b][m][n] = (f32x4){0.f, 0.f, 0.f, 0.f};
        cur = nxt; cA = nA; cB = nB; ++ui;
        if constexpr (ALIGN_EPI) { if (wr == 1) PG8_BAR; }
    }
    PG8_WAIT_V(0);
    if constexpr (!ALIGN_EPI) { if (wr == 0) PG8_BAR; }
    PG8_BAR;
#undef PG8_SA
#undef PG8_SB
#undef PG8_STAGE
#undef PG8_LDA
#undef PG8_LDB
#undef PG8_MMA
#undef PG8_WAIT_V
#undef PG8_WAIT_L
#undef PG8_BAR
#undef PG8_SCHED
}
}
namespace fa {
#define FA_LAS __attribute__((address_space(3)))
typedef unsigned short bf16_t;
typedef short bf16x8 __attribute__((ext_vector_type(8)));
typedef short s16x4 __attribute__((ext_vector_type(4)));
typedef float f32x16 __attribute__((ext_vector_type(16)));
typedef unsigned u32x4 __attribute__((ext_vector_type(4)));
typedef float f32x2_t __attribute__((ext_vector_type(2)));
typedef __bf16 bf16x2_t __attribute__((ext_vector_type(2)));
typedef FA_LAS unsigned char lds_u8;
#define DI __device__ __forceinline__
DI int crow(int r, int hi) { return (r & 3) + 8 * (r >> 2) + 4 * hi; }
DI unsigned cvtpk(float lo, float hi) { f32x2_t v = {lo, hi}; bf16x2_t b = __builtin_convertvector(v, bf16x2_t); return __builtin_bit_cast(unsigned, b); }
DI s16x4 vtr(const lds_u8* p) { return __builtin_bit_cast(s16x4, __builtin_amdgcn_ds_read_tr16_b64_v4i16((FA_LAS s16x4*)p)); }
DI bf16x8 frag_rm(const lds_u8* base, int row, int ch, int rowbytes) { return *(const FA_LAS bf16x8*)(base + row * rowbytes + (ch << 4)); }
DI f32x16 splat16(float v) { f32x16 r; _Pragma("unroll") for (int i = 0; i < 16; ++i) r[i] = v; return r; }
DI float rowmax32(const f32x16& a, const f32x16& b) {
    float m = fmaxf(a[0], b[0]);
#pragma unroll
    for (int r = 1; r < 16; ++r) m = fmaxf(m, fmaxf(a[r], b[r]));
    return fmaxf(m, __shfl_xor(m, 32));
}
DI int t5_bucket(int rel) { const int n = rel < 0 ? -rel : rel; int b; if (n < 8) b = n; else { const int l2 = 31 - __builtin_clz((unsigned)(n * n)); b = 2 + l2; if (b > 15) b = 15; } return b + (rel > 0 ? 16 : 0); }

constexpr float LOG2E = 1.4426950408889634f;
constexpr int RB = 192;

template <int DQK, bool DIFF> struct Cfg {
    static constexpr int NCH = DQK / 8, KROWB = DQK * 2 + 16, NKV = DIFF ? 2 : 1, KT_BYTES = 64 * KROWB,
                         NVB = DIFF ? 4 : 8, V_BYTES = NVB * 4096, STAGE = NKV * KT_BYTES + V_BYTES,
                         KREG = NKV * 64 * NCH / 512, VREG = NVB * 256 / 512, NDS = DQK / 16;
    static constexpr int OFF_WSF = 2 * STAGE, OFF_TAB = OFF_WSF + 8 * 128, OFF_X = 0;
};

struct UnitArgs {
    const bf16_t* Q; int qpitch; int qcol0, qcol1; long qrow0;
    const bf16_t* K; int kpitch; int kcol0, kcol1;
    const bf16_t* V; int vpitch; int vcol0;
    long krow0; int nkeys;
    bf16_t* O; int opitch; int ocol;
    int qpos0;
    const float* relb; int head;
    float lam; const float* subw;
};

template <int DQK, bool DIFF>
DI void attn_unit(lds_u8* lds, const UnitArgs& a) {
    typedef Cfg<DQK, DIFF> C;
    const int tid = threadIdx.x, lane = tid & 63, r32 = lane & 31, hi = lane >> 5;
    const int wid = __builtin_amdgcn_readfirstlane(tid >> 6), qb = wid & 3, var = wid >> 2;
    volatile FA_LAS float* wsf = (volatile FA_LAS float*)(lds + C::OFF_WSF) + wid * 32;
    FA_LAS float* tab = (FA_LAS float*)(lds + C::OFF_TAB);
    const int NT = a.nkeys / 64;
    constexpr int NQF = DIFF ? C::NDS : 1;
    bf16x8 qf[NQF];
    const bf16_t* qp = a.Q + (a.qrow0 + qb * 32 + r32) * (long)a.qpitch + (var ? a.qcol1 : a.qcol0) + hi * 8;
    if (DIFF) {
#pragma unroll
      for (int ds = 0; ds < NQF; ++ds) qf[ds] = *(const bf16x8*)(qp + ds * 16); }
    if (DIFF) { for (int i = tid; i < 2 * RB + 1; i += 512) tab[i] = a.relb[t5_bucket(i - RB) * 8 + a.head] * LOG2E; }
    float bcl = 0.f, bcr = 0.f;
    if (DIFF) { bcl = a.relb[15 * 8 + a.head] * LOG2E; bcr = a.relb[31 * 8 + a.head] * LOG2E; }
    u32x4 kreg[C::KREG], vreg[C::VREG];
#define FA_GLOAD(t) do { \
      _Pragma("unroll") for (int i = 0; i < C::KREG; ++i) { const int pid = tid + 512 * i, kv = pid / (64 * C::NCH), rem = pid % (64 * C::NCH), key = rem / C::NCH, ch = rem % C::NCH; \
          kreg[i] = *(const u32x4*)(a.K + (a.krow0 + (long)(t) * 64 + key) * a.kpitch + (kv ? a.kcol1 : a.kcol0) + ch * 8); } \
      _Pragma("unroll") for (int i = 0; i < C::VREG; ++i) { const int pid = tid + 512 * i, piece = pid >> 6, l6 = pid & 63, key = 16 * (piece & 3) + (l6 >> 2), col = (piece >> 2) * 32 + (l6 & 3) * 8; \
          vreg[i] = *(const u32x4*)(a.V + (a.krow0 + (long)(t) * 64 + key) * a.vpitch + a.vcol0 + col); } } while (0)
#define FA_LSTORE(buf) do { lds_u8* sb_ = lds + (buf) * C::STAGE; \
      _Pragma("unroll") for (int i = 0; i < C::KREG; ++i) { const int pid = tid + 512 * i, kv = pid / (64 * C::NCH), rem = pid % (64 * C::NCH), key = rem / C::NCH, ch = rem % C::NCH; \
          *(FA_LAS u32x4*)(sb_ + kv * C::KT_BYTES + key * C::KROWB + (ch << 4)) = kreg[i]; } \
      _Pragma("unroll") for (int i = 0; i < C::VREG; ++i) { const int pid = tid + 512 * i; *(FA_LAS u32x4*)(sb_ + C::NKV * C::KT_BYTES + pid * 16) = vreg[i]; } } while (0)
    FA_GLOAD(0); FA_LSTORE(0);
    __syncthreads();
    float mhat = 0.f, lsum = 0.f;
    f32x16 o[4];
#pragma unroll
    for (int d0 = 0; d0 < 4; ++d0) o[d0] = splat16(0.f);
    const int qpw = a.qpos0 + qb * 32;
    const int vlane = ((lane >> 4) & 1) * 32 + (lane & 3) * 8 + (4 * hi + ((lane & 15) >> 2)) * 64;
    for (int t = 0; t < NT; ++t) {
        const int buf = t & 1;
        if (DIFF && t + 1 < NT) FA_GLOAD(t + 1);
        const lds_u8* sb = lds + buf * C::STAGE;
        const lds_u8* kb = sb + (DIFF ? var : 0) * C::KT_BYTES;
        int bmode = 0; float cini = -mhat;
        if (DIFF) { const int k0 = t * 64; if (k0 + 63 <= qpw - 91) cini += bcl; else if (k0 >= qpw + 31 + 91) cini += bcr; else bmode = 1; }
        f32x16 c0 = splat16(cini), c1 = c0;
        const bf16_t* qpt = qp; if (!DIFF) asm volatile("" : "+v"(qpt));
#pragma unroll
        for (int ds = 0; ds < C::NDS; ++ds) {
            const bf16x8 a0 = frag_rm(kb, r32, 2 * ds + hi, C::KROWB), a1 = frag_rm(kb, 32 + r32, 2 * ds + hi, C::KROWB);
            bf16x8 qv; if (DIFF) qv = qf[DIFF ? ds : 0]; else qv = *(const bf16x8*)(qpt + ds * 16);
            c0 = __builtin_amdgcn_mfma_f32_32x32x16_bf16(a0, qv, c0, 0, 0, 0);
            c1 = __builtin_amdgcn_mfma_f32_32x32x16_bf16(a1, qv, c1, 0, 0, 0);
        }
        if (DIFF && bmode) {
            const int relb0 = t * 64 - (qpw + r32) + RB;
#pragma unroll
            for (int r = 0; r < 16; ++r) { int i0 = relb0 + crow(r, hi), i1 = i0 + 32; i0 = i0 < 0 ? 0 : (i0 > 2 * RB ? 2 * RB : i0); i1 = i1 < 0 ? 0 : (i1 > 2 * RB ? 2 * RB : i1);
                c0[r] += tab[i0]; c1[r] += tab[i1]; }
        }
        const float rm = rowmax32(c0, c1);
        const bool need = (t == 0) || __any(rm > 6.0f);
        if (need) {
            const float dl = (t == 0) ? rm : fmaxf(rm, 0.f);
            mhat += dl;
#pragma unroll
            for (int r = 0; r < 16; ++r) { c0[r] -= dl; c1[r] -= dl; }
            if (t != 0) {
                const float f = __builtin_amdgcn_exp2f(-dl); lsum *= f;
                if (hi == 0) wsf[r32] = f;
                float fr[16];
#pragma unroll
                for (int r = 0; r < 16; ++r) fr[r] = wsf[crow(r, hi)];
#pragma unroll
                for (int d0 = 0; d0 < 4; ++d0)
#pragma unroll
                    for (int r = 0; r < 16; ++r) o[d0][r] *= fr[r];
            }
        }
        float ps = 0.f;
#pragma unroll
        for (int r = 0; r < 16; ++r) { c0[r] = __builtin_amdgcn_exp2f(c0[r]); c1[r] = __builtin_amdgcn_exp2f(c1[r]); ps += c0[r] + c1[r]; }
        lsum += ps;
        u32x4 pw[4];
#pragma unroll
        for (int j = 0; j < 4; ++j) { pw[0][j] = cvtpk(c0[2 * j], c0[2 * j + 1]); pw[1][j] = cvtpk(c0[8 + 2 * j], c0[9 + 2 * j]); pw[2][j] = cvtpk(c1[2 * j], c1[2 * j + 1]); pw[3][j] = cvtpk(c1[8 + 2 * j], c1[9 + 2 * j]); }
        const lds_u8* vb = sb + C::NKV * C::KT_BYTES + (DIFF ? 0 : var * 4 * 4096) + vlane;
#pragma unroll
        for (int d0 = 0; d0 < 4; ++d0) {
#pragma unroll
            for (int ks = 0; ks < 4; ++ks) {
                const s16x4 lo = vtr(vb + d0 * 4096 + ks * 1024), hh = vtr(vb + d0 * 4096 + ks * 1024 + 512);
                const bf16x8 vf = (bf16x8){lo[0], lo[1], lo[2], lo[3], hh[0], hh[1], hh[2], hh[3]};
                o[d0] = __builtin_amdgcn_mfma_f32_32x32x16_bf16(__builtin_bit_cast(bf16x8, pw[ks]), vf, o[d0], 0, 0, 0);
            }
        }
        if (!DIFF && t + 1 < NT) FA_GLOAD(t + 1);
        if (t + 1 < NT) FA_LSTORE(buf ^ 1);
        __syncthreads();
    }
#undef FA_GLOAD
#undef FA_LSTORE
    const float ltot = lsum + __shfl_xor(lsum, 32);
    const float inv = (DIFF && var) ? a.lam / ltot : 1.0f / ltot;
    if (hi == 0) wsf[r32] = inv;
    float fr[16];
#pragma unroll
    for (int r = 0; r < 16; ++r) fr[r] = wsf[crow(r, hi)];
    if (DIFF) {
        FA_LAS float* X = (FA_LAS float*)(lds + C::OFF_X);
        if (var == 1) {
#pragma unroll
            for (int d0 = 0; d0 < 4; ++d0)
#pragma unroll
                for (int r = 0; r < 16; ++r) X[(qb * 32 + crow(r, hi)) * 128 + d0 * 32 + r32] = o[d0][r] * fr[r];
        }
        __syncthreads();
        if (var == 0) {
            float ss[16];
#pragma unroll
            for (int r = 0; r < 16; ++r) ss[r] = 0.f;
#pragma unroll
            for (int d0 = 0; d0 < 4; ++d0)
#pragma unroll
                for (int r = 0; r < 16; ++r) { const float d = o[d0][r] * fr[r] - X[(qb * 32 + crow(r, hi)) * 128 + d0 * 32 + r32]; o[d0][r] = d; ss[r] += d * d; }
#pragma unroll
            for (int r = 0; r < 16; ++r) { float s = ss[r]; s += __shfl_xor(s, 1); s += __shfl_xor(s, 2); s += __shfl_xor(s, 4); s += __shfl_xor(s, 8); s += __shfl_xor(s, 16);
                ss[r] = __builtin_amdgcn_rsqf(s * (1.0f / 128.0f) + 1e-6f) * 0.8f; }
#pragma unroll
            for (int d0 = 0; d0 < 4; ++d0) { const float w = a.subw[d0 * 32 + r32];
#pragma unroll
                for (int r = 0; r < 16; ++r) { const float v = o[d0][r] * ss[r] * w;
                    a.O[(a.qrow0 + qb * 32 + crow(r, hi)) * (long)a.opitch + a.ocol + d0 * 32 + r32] = (bf16_t)(cvtpk(v, v) & 0xffffu); } }
        }
    } else {
#pragma unroll
        for (int d0 = 0; d0 < 4; ++d0)
#pragma unroll
            for (int r = 0; r < 16; ++r) { const float v = o[d0][r] * fr[r];
                a.O[(a.qrow0 + qb * 32 + crow(r, hi)) * (long)a.opitch + a.ocol + var * 128 + d0 * 32 + r32] = (bf16_t)(cvtpk(v, v) & 0xffffu); }
    }
    __syncthreads();
}
#undef DI
}
namespace hg {
#define HG_LAS __attribute__((address_space(3)))
typedef unsigned short bf16_t;
typedef short bf16x8 __attribute__((ext_vector_type(8)));
typedef short s16x4 __attribute__((ext_vector_type(4)));
typedef float f32x16 __attribute__((ext_vector_type(16)));
typedef unsigned u32x4 __attribute__((ext_vector_type(4)));
typedef unsigned u32x2 __attribute__((ext_vector_type(2)));
typedef HG_LAS unsigned char lds_u8;
#define DI __device__ __forceinline__
using fa::crow; using fa::cvtpk; using fa::vtr; using fa::frag_rm; using fa::splat16;
constexpr int RP = 272;
constexpr int OFF_QP = 0, OFF_QPP = 17408, OFF_KPR = 34816, OFF_KPV = 52224, OFF_VV = 68608, OFF_SBT = 84992, OFF_SEG = 119808, OFF_EM = 123904, OFF_EL = 124416, HG_LDS = 124928;
constexpr float LOG2E = 1.4426950408889634f, LN2 = 0.6931471805599453f;
DI float bflo(unsigned w) { return __uint_as_float(w << 16); }
DI float bfhi(unsigned w) { return __uint_as_float(w & 0xffff0000u); }
DI int rm_off(int row, int k) { return row * RP + k * 2; }
DI int vs_off(int row, int col) { return (col >> 5) * 4096 + (row >> 4) * 1024 + (row & 15) * 64 + (col & 31) * 2; }

struct Args {
    const bf16_t* Bq; const bf16_t* Bf; const bf16_t* Bi; int pitch;
    bf16_t* O; int opitch; int ocol;
    const float* lb;
    int b, h, dir;
};

DI void hgrn_unit(lds_u8* lds, const Args& a) {
    const int tid = threadIdx.x, lane = tid & 63, r32 = lane & 31, hi = lane >> 5;
    const int wid = __builtin_amdgcn_readfirstlane(tid >> 6);
    const int cp = lane, seg = wid;
    const int k0 = 2 * cp;
    const int ct = wid & 1, vb = wid >> 1;
    const int kt = wid & 3, vs0 = 2 * (wid >> 2);
    const int dir = a.dir;
    const float lb0 = a.lb[a.h * 128 + k0], lb1 = a.lb[a.h * 128 + k0 + 1];
    FA_LAS float* SEG = (FA_LAS float*)(lds + OFF_SEG);
    FA_LAS float* EM = (FA_LAS float*)(lds + OFF_EM);
    FA_LAS float* EL = (FA_LAS float*)(lds + OFF_EL);
    const long tokb = (long)a.b * 4096;
    const int colh = a.h * 128;
    f32x16 S[2]; S[0] = splat16(0.f); S[1] = splat16(0.f);
    for (int i = tid; i < 128 * RP / 16; i += 512) *(FA_LAS u32x4*)(lds + OFF_SBT + i * 16) = (u32x4){0u, 0u, 0u, 0u};
    unsigned xr[8], qr[8]; u32x4 vr[2];
#define HG_GLOAD(n) do { const int m_ = dir ? 63 - (n) : (n); const long t0_ = tokb + (long)m_ * 64; \
      _Pragma("unroll") for (int i = 0; i < 8; ++i) { const int p = 8 * seg + i, orow = dir ? 63 - p : p; \
          xr[i] = *(const unsigned*)(a.Bf + (t0_ + orow) * a.pitch + colh + k0); qr[i] = *(const unsigned*)(a.Bq + (t0_ + orow) * a.pitch + colh + k0); } \
      _Pragma("unroll") for (int j = 0; j < 2; ++j) { const int pid = tid + 512 * j, piece = pid >> 6, l6 = pid & 63, row = 16 * (piece & 3) + (l6 >> 2), col = (piece >> 2) * 32 + (l6 & 3) * 8; \
          vr[j] = *(const u32x4*)(a.Bi + (t0_ + row) * a.pitch + colh + col); } } while (0)
    HG_GLOAD(0);
    for (int n = 0; n < 64; ++n) {
        const int m = dir ? 63 - n : n;
        float g0[8], g1[8], kk0[8], kk1[8], q0[8], q1[8];
        float c0 = 0.f, c1 = 0.f;
#pragma unroll
        for (int i = 0; i < 8; ++i) {
            const float x0 = bflo(xr[i]), x1 = bfhi(xr[i]);
            const float s0 = __builtin_amdgcn_rcpf(1.0f + __builtin_amdgcn_exp2f(-LOG2E * x0)), s1 = __builtin_amdgcn_rcpf(1.0f + __builtin_amdgcn_exp2f(-LOG2E * x1));
            const float f0 = lb0 + (1.0f - lb0) * s0, f1 = lb1 + (1.0f - lb1) * s1;
            c0 += __builtin_amdgcn_logf(f0) * LN2; c1 += __builtin_amdgcn_logf(f1) * LN2;
            g0[i] = c0; g1[i] = c1;
            kk0[i] = 1.0f - f0; kk1[i] = 1.0f - f1;
            q0[i] = bflo(qr[i]); q1[i] = bfhi(qr[i]);
        }
        SEG[seg * 128 + k0] = c0; SEG[seg * 128 + k0 + 1] = c1;
#pragma unroll
        for (int j = 0; j < 2; ++j) *(FA_LAS u32x4*)(lds + OFF_VV + (tid + 512 * j) * 16) = vr[j];
        __syncthreads();
        if (n + 1 < 64) HG_GLOAD(n + 1);
        float pre0 = 0.f, pre1 = 0.f, bm0 = 0.f, bm1 = 0.f, bl0 = 0.f, bl1 = 0.f;
#pragma unroll
        for (int s = 0; s < 8; ++s) { const float t0 = SEG[s * 128 + k0], t1 = SEG[s * 128 + k0 + 1];
            if (s < seg) { pre0 += t0; pre1 += t1; } if (s < 4) { bm0 += t0; bm1 += t1; } bl0 += t0; bl1 += t1; }
        const float em0 = __builtin_amdgcn_exp2f(LOG2E * bm0), em1 = __builtin_amdgcn_exp2f(LOG2E * bm1);
        if (seg == 0) { EM[k0] = em0; EM[k0 + 1] = em1; EL[k0] = __builtin_amdgcn_exp2f(LOG2E * (bl0 - bm0)); EL[k0 + 1] = __builtin_amdgcn_exp2f(LOG2E * (bl1 - bm1)); }
#pragma unroll
        for (int i = 0; i < 8; ++i) {
            const int p = 8 * seg + i, orow = dir ? 63 - p : p;
            const float e0 = __builtin_amdgcn_exp2f(LOG2E * (pre0 + g0[i] - bm0)), e1 = __builtin_amdgcn_exp2f(LOG2E * (pre1 + g1[i] - bm1));
            const float qp0 = q0[i] * e0, qp1 = q1[i] * e1;
            const float kp0 = kk0[i] * __builtin_amdgcn_rcpf(e0), kp1 = kk1[i] * __builtin_amdgcn_rcpf(e1);
            const int ro = rm_off(orow, k0);
            *(FA_LAS unsigned*)(lds + OFF_QP + ro) = cvtpk(qp0, qp1);
            *(FA_LAS unsigned*)(lds + OFF_QPP + ro) = cvtpk(qp0 * em0, qp1 * em1);
            const unsigned kpw = cvtpk(kp0, kp1);
            *(FA_LAS unsigned*)(lds + OFF_KPR + ro) = kpw;
            *(FA_LAS unsigned*)(lds + OFF_KPV + vs_off(orow, k0)) = kpw;
        }
        __syncthreads();
        u32x4 pw[4];
        bool have[2];
#pragma unroll
        for (int st = 0; st < 2; ++st) {
            have[st] = dir ? (st >= ct) : (st <= ct);
            if (have[st]) {
                f32x16 acc = splat16(0.f);
#pragma unroll
                for (int ks = 0; ks < 8; ++ks) {
                    const bf16x8 af = frag_rm(lds + OFF_KPR, 32 * st + r32, 2 * ks + hi, RP), bfq = frag_rm(lds + OFF_QP, 32 * ct + r32, 2 * ks + hi, RP);
                    acc = __builtin_amdgcn_mfma_f32_32x32x16_bf16(af, bfq, acc, 0, 0, 0);
                }
                const int cc = 32 * ct + r32;
#pragma unroll
                for (int r = 0; r < 16; ++r) { const int s = 32 * st + crow(r, hi); const bool keep = dir ? (s >= cc) : (s <= cc); if (!keep) acc[r] = 0.f; }
#pragma unroll
                for (int j = 0; j < 4; ++j) { pw[2 * st][j] = cvtpk(acc[2 * j], acc[2 * j + 1]); pw[2 * st + 1][j] = cvtpk(acc[8 + 2 * j], acc[9 + 2 * j]); }
            }
        }
        f32x16 o = splat16(0.f);
        const int vlane = ((lane >> 4) & 1) * 32 + (lane & 3) * 8 + (4 * hi + ((lane & 15) >> 2)) * 64;
#pragma unroll
        for (int ks = 0; ks < 4; ++ks) {
            if (have[ks >> 1]) {
                const lds_u8* vp = lds + OFF_VV + vb * 4096 + ks * 1024 + vlane;
                const s16x4 lo = vtr(vp), hh = vtr(vp + 512);
                const bf16x8 vf = (bf16x8){lo[0], lo[1], lo[2], lo[3], hh[0], hh[1], hh[2], hh[3]};
                o = __builtin_amdgcn_mfma_f32_32x32x16_bf16(__builtin_bit_cast(bf16x8, pw[ks]), vf, o, 0, 0, 0);
            }
        }
#pragma unroll
        for (int ks = 0; ks < 8; ++ks) {
            const bf16x8 af = frag_rm(lds + OFF_QPP, 32 * ct + r32, 2 * ks + hi, RP), bs = frag_rm(lds + OFF_SBT, 32 * vb + r32, 2 * ks + hi, RP);
            o = __builtin_amdgcn_mfma_f32_32x32x16_bf16(af, bs, o, 0, 0, 0);
        }
        { const long t0 = tokb + (long)m * 64;
#pragma unroll
          for (int r = 0; r < 16; ++r) a.O[(t0 + 32 * ct + crow(r, hi)) * a.opitch + a.ocol + colh + 32 * vb + r32] = (bf16_t)(cvtpk(o[r], o[r]) & 0xffffu); }
        float emr[16], elr[16];
#pragma unroll
        for (int r = 0; r < 16; ++r) { emr[r] = EM[32 * kt + crow(r, hi)]; elr[r] = EL[32 * kt + crow(r, hi)]; }
#pragma unroll
        for (int jj = 0; jj < 2; ++jj) {
#pragma unroll
            for (int r = 0; r < 16; ++r) S[jj][r] *= emr[r];
#pragma unroll
            for (int ks = 0; ks < 4; ++ks) {
                const lds_u8* kp = lds + OFF_KPV + kt * 4096 + ks * 1024 + vlane;
                const lds_u8* vp = lds + OFF_VV + (vs0 + jj) * 4096 + ks * 1024 + vlane;
                const s16x4 klo = vtr(kp), khi = vtr(kp + 512), vlo = vtr(vp), vhi = vtr(vp + 512);
                const bf16x8 kf = (bf16x8){klo[0], klo[1], klo[2], klo[3], khi[0], khi[1], khi[2], khi[3]};
                const bf16x8 vf = (bf16x8){vlo[0], vlo[1], vlo[2], vlo[3], vhi[0], vhi[1], vhi[2], vhi[3]};
                S[jj] = __builtin_amdgcn_mfma_f32_32x32x16_bf16(kf, vf, S[jj], 0, 0, 0);
            }
#pragma unroll
            for (int r = 0; r < 16; ++r) S[jj][r] *= elr[r];
        }
        __syncthreads();
#pragma unroll
        for (int jj = 0; jj < 2; ++jj) { const int v = 32 * (vs0 + jj) + r32;
#pragma unroll
            for (int g = 0; g < 4; ++g) { const int k = 32 * kt + 8 * g + 4 * hi;
                *(FA_LAS u32x2*)(lds + OFF_SBT + rm_off(v, k)) = (u32x2){cvtpk(S[jj][4 * g], S[jj][4 * g + 1]), cvtpk(S[jj][4 * g + 2], S[jj][4 * g + 3])}; } }
    }
#undef HG_GLOAD
    __syncthreads();
}
#undef DI
}
namespace nv {
#define NV_LAS __attribute__((address_space(3)))
typedef unsigned short bf16_t;
__device__ __forceinline__ float bf2f(bf16_t v) { return __uint_as_float(((unsigned)v) << 16); }
__device__ __forceinline__ bf16_t f2bf_(float f) { unsigned u = __builtin_bit_cast(unsigned, f); return (bf16_t)((u + 0x7fffu + ((u >> 16) & 1u)) >> 16); }
__device__ __forceinline__ void hgrn_naive(NV_LAS unsigned char* lds, const hg::Args& a) {
    const int tid = threadIdx.x, v = tid & 127, kg = tid >> 7;
    NV_LAS float* F = (NV_LAS float*)lds; NV_LAS float* KK = F + 128; NV_LAS float* Q = KK + 128; NV_LAS float* PO = Q + 128;
    float S[32];
#pragma unroll
    for (int i = 0; i < 32; ++i) S[i] = 0.f;
    const float lb = a.lb[a.h * 128 + (tid & 127)];
    for (int p = 0; p < 4096; ++p) {
        const int t = a.dir ? 4095 - p : p;
        const long row = (long)a.b * 4096 + t;
        if (tid < 128) {
            const float x = bf2f(a.Bf[row * a.pitch + a.h * 128 + tid]);
            const float sg = 1.0f / (1.0f + expf(-x));
            const float f = lb + (1.0f - lb) * sg;
            F[tid] = f; KK[tid] = 1.0f - f; Q[tid] = bf2f(a.Bq[row * a.pitch + a.h * 128 + tid]);
        }
        const float vv = bf2f(a.Bi[row * a.pitch + a.h * 128 + v]);
        __syncthreads();
        float po = 0.f;
#pragma unroll
        for (int i = 0; i < 32; ++i) { const int k = kg * 32 + i; S[i] = F[k] * S[i] + KK[k] * vv; po += Q[k] * S[i]; }
        PO[kg * 128 + v] = po;
        __syncthreads();
        if (kg == 0) a.O[row * a.opitch + a.ocol + a.h * 128 + v] = f2bf_(PO[v] + PO[128 + v] + PO[256 + v] + PO[384 + v]);
    }
    __syncthreads();
}
__device__ __forceinline__ void cross_naive_row(NV_LAS float* pl  , const bf16_t* Q, const bf16_t* MK, const bf16_t* MV, bf16_t* O, int lane) {
    float s[4];
#pragma unroll
    for (int j = 0; j < 4; ++j) { const int key = lane * 4 + j; float acc = 0.f; for (int d = 0; d < 256; ++d) acc += bf2f(Q[d]) * bf2f(MK[(long)key * 1024 + d]); s[j] = acc; }
    float m = fmaxf(fmaxf(s[0], s[1]), fmaxf(s[2], s[3]));
#pragma unroll
    for (int o = 1; o < 64; o <<= 1) m = fmaxf(m, __shfl_xor(m, o));
    float l = 0.f;
#pragma unroll
    for (int j = 0; j < 4; ++j) { s[j] = exp2f(s[j] - m); l += s[j]; }
#pragma unroll
    for (int o = 1; o < 64; o <<= 1) l += __shfl_xor(l, o);
#pragma unroll
    for (int j = 0; j < 4; ++j) pl[lane * 4 + j] = s[j] / l;
    float acc[4] = {0.f, 0.f, 0.f, 0.f};
    for (int key = 0; key < 256; ++key) { const float pk = pl[key];
#pragma unroll
        for (int j = 0; j < 4; ++j) acc[j] += pk * bf2f(MV[(long)key * 1024 + lane * 4 + j]); }
#pragma unroll
    for (int j = 0; j < 4; ++j) O[lane * 4 + j] = f2bf_(acc[j]);
}
__device__ __forceinline__ void diff_naive_row(NV_LAS float* wl  , const bf16_t* q0p, const bf16_t* q1p, const bf16_t* K, int kc0, int kc1, const bf16_t* V, int vc,
                                               int qpos, const float* relb, int head, float lam, const float* subw, bf16_t* O, int lane) {
    NV_LAS float* qs = wl + 4096;
    qs[lane] = bf2f(q0p[lane]); qs[64 + lane] = bf2f(q1p[lane]);
    float m0 = -1e30f, m1 = -1e30f, l0 = 0.f, l1 = 0.f;
    for (int i = 0; i < 64; ++i) { const int key = lane + 64 * i; const bf16_t* k0 = K + (long)key * 1024 + kc0; const bf16_t* k1 = K + (long)key * 1024 + kc1;
        float s0 = 0.f, s1 = 0.f; for (int d = 0; d < 64; ++d) { s0 += qs[d] * bf2f(k0[d]); s1 += qs[64 + d] * bf2f(k1[d]); }
        const float bias = relb[fa::t5_bucket(key - qpos) * 8 + head] * 1.4426950408889634f; s0 += bias; s1 += bias;
        if (s0 > m0) { l0 *= exp2f(m0 - s0); m0 = s0; } l0 += exp2f(s0 - m0);
        if (s1 > m1) { l1 *= exp2f(m1 - s1); m1 = s1; } l1 += exp2f(s1 - m1); }
    float M0 = m0, M1 = m1;
#pragma unroll
    for (int o = 1; o < 64; o <<= 1) { M0 = fmaxf(M0, __shfl_xor(M0, o)); M1 = fmaxf(M1, __shfl_xor(M1, o)); }
    l0 *= exp2f(m0 - M0); l1 *= exp2f(m1 - M1);
#pragma unroll
    for (int o = 1; o < 64; o <<= 1) { l0 += __shfl_xor(l0, o); l1 += __shfl_xor(l1, o); }
    for (int i = 0; i < 64; ++i) { const int key = lane + 64 * i; const bf16_t* k0 = K + (long)key * 1024 + kc0; const bf16_t* k1 = K + (long)key * 1024 + kc1;
        float s0 = 0.f, s1 = 0.f; for (int d = 0; d < 64; ++d) { s0 += qs[d] * bf2f(k0[d]); s1 += qs[64 + d] * bf2f(k1[d]); }
        const float bias = relb[fa::t5_bucket(key - qpos) * 8 + head] * 1.4426950408889634f; s0 += bias; s1 += bias;
        wl[key] = exp2f(s0 - M0) / l0 - lam * exp2f(s1 - M1) / l1; }
    float a0 = 0.f, a1 = 0.f;
    for (int key = 0; key < 4096; ++key) { const float w = wl[key]; const unsigned vv = *(const unsigned*)(V + (long)key * 1024 + vc + 2 * lane);
        a0 += w * __uint_as_float(vv << 16); a1 += w * __uint_as_float(vv & 0xffff0000u); }
    float ss = a0 * a0 + a1 * a1;
#pragma unroll
    for (int o = 1; o < 64; o <<= 1) ss += __shfl_xor(ss, o);
    const float rstd = 0.8f / sqrtf(ss * (1.f / 128.f) + 1e-6f);
    O[2 * lane] = f2bf_(a0 * rstd * subw[2 * lane]); O[2 * lane + 1] = f2bf_(a1 * rstd * subw[2 * lane + 1]);
}
}
constexpr int D = 1024, BATCH = 4, SEQ = 4096, M_TOK = BATCH * SEQ, NMEM = 256, INC = 14336;
constexpr size_t MiB = 1u << 20;
constexpr size_t WS_TAB = 0;
constexpr size_t WS_WIN = 1 * MiB;
constexpr size_t WS_WBR = 29 * MiB;
constexpr size_t WS_WOUT = 35 * MiB;
constexpr size_t WS_WMEM = 37 * MiB;
constexpr size_t WS_MK = 41 * MiB, WS_MV = 43 * MiB;
constexpr size_t WS_MN = 45 * MiB;
constexpr size_t WS_H = 47 * MiB;
constexpr size_t WS_OG = 79 * MiB;
constexpr size_t WS_T1 = 175 * MiB;
constexpr size_t WS_END = 239 * MiB;
static_assert(WS_END <= 256 * MiB, "ws map");
constexpr int LDS_BYTES = 147456;
#ifdef NAIVE_HGRN
#define HGRN_CALL nv::hgrn_naive
#else
#define HGRN_CALL hg::hgrn_unit
#endif

typedef unsigned short bf16;
typedef float f32x4v __attribute__((ext_vector_type(4)));
typedef unsigned v4u __attribute__((ext_vector_type(4)));
#define LAS __attribute__((address_space(3)))
#define GAS __attribute__((address_space(1)))

struct Params {
    const float *x, *mem, *pre_norm, *post_norm, *w_in, *lq1, *lk1, *lq2, *lk2, *subln, *relb, *lbl, *hnorm, *mnorm, *w_memkv, *w_branch, *w_out;
    float* out; unsigned char* ws; int ph_lo, ph_hi;
};

__device__ __forceinline__ unsigned f2bf(float f) { unsigned u = __builtin_bit_cast(unsigned, f); return (u + 0x7fffu + ((u >> 16) & 1u)) >> 16; }
__device__ __forceinline__ unsigned pk2(float lo, float hi) { return f2bf(lo) | (f2bf(hi) << 16); }
__device__ __forceinline__ float wave_sum(float v) {
#pragma unroll
    for (int o = 1; o < 64; o <<= 1) v += __shfl_xor(v, o);
    return v;
}
__device__ __forceinline__ int win_dst_row(int n0) {
    const int seg = n0 >> 10, w = n0 & 1023;
    const int perm = ((w >> 6) & 7) * 128 + (w >> 9) * 64 + (w & 63);
    switch (seg) {
        case 0: return 5120 + perm; case 1: return 6144 + perm; case 2: return 7168 + w; case 3: return 8192 + w;
        case 4: return 0 + w; case 5: return 1024 + w; case 6: return 2048 + w; case 7: return 3072 + w; case 8: return 9216 + w;
        case 9: return 4096 + w; case 10: return 10240 + w; case 11: return 11264 + w; case 12: return 12288 + w; default: return 13312 + w;
    }
}
__device__ __forceinline__ void p0_transpose_item(const float* W, int K, int N, bf16* WT, int dst_row0, int kb, int n0, LAS float* scr, int lane) {
    const int k0 = 64 * kb;
#pragma unroll 8
    for (int i = 0; i < 32; ++i) { const int kk = 2 * i + (lane >> 5); scr[kk * 33 + (lane & 31)] = W[(size_t)(k0 + kk) * N + n0 + (lane & 31)]; }
    asm volatile("s_waitcnt lgkmcnt(0)" ::: "memory");
    const int c = lane & 7;
#pragma unroll
    for (int j = 0; j < 4; ++j) { const int n = (lane >> 3) + 8 * j; const LAS float* s = scr + (8 * c) * 33 + n;
        v4u o; o.x = pk2(s[0 * 33], s[1 * 33]); o.y = pk2(s[2 * 33], s[3 * 33]); o.z = pk2(s[4 * 33], s[5 * 33]); o.w = pk2(s[6 * 33], s[7 * 33]);
        *(v4u*)(WT + (size_t)(dst_row0 + n) * K + k0 + 8 * c) = o; }
    asm volatile("s_waitcnt lgkmcnt(0)" ::: "memory");
}
__device__ __forceinline__ void rms_row_to_bf16(const float* xrow, const float* w, bf16* orow, int lane) {
    const f32x4v* xr = (const f32x4v*)xrow + lane; const f32x4v* wr = (const f32x4v*)w + lane;
    f32x4v v[4]; float s = 0.f;
#pragma unroll
    for (int j = 0; j < 4; ++j) { v[j] = xr[64 * j]; s += (v[j].x * v[j].x + v[j].y * v[j].y) + (v[j].z * v[j].z + v[j].w * v[j].w); }
    const float rstd = 1.0f / sqrtf(wave_sum(s) * (1.f / 1024.f) + 1e-6f);
    unsigned long long* o8 = (unsigned long long*)orow + lane;
#pragma unroll
    for (int j = 0; j < 4; ++j) { const f32x4v ww = wr[64 * j];
        o8[64 * j] = (unsigned long long)pk2(v[j].x * rstd * ww.x, v[j].y * rstd * ww.y) | ((unsigned long long)pk2(v[j].z * rstd * ww.z, v[j].w * rstd * ww.w) << 32); }
}

__global__ void __launch_bounds__(512, 2) fwd_kernel(Params p) {
    extern __shared__ __attribute__((aligned(16))) unsigned char lds_raw[];
    LAS unsigned char* lds = (LAS unsigned char*)lds_raw;
    cg::grid_group grid = cg::this_grid();
    const int tid = threadIdx.x, lane = tid & 63, wave = __builtin_amdgcn_readfirstlane(tid >> 6);
    const int G = gridDim.x, bx = blockIdx.x;
    const int vcu = (G % 8 == 0) ? (bx % 8) * (G / 8) + bx / 8 : bx;
    unsigned char* ws = p.ws;
    float* TAB = (float*)(ws + WS_TAB);
    bf16* WinT = (bf16*)(ws + WS_WIN); bf16* WbrT = (bf16*)(ws + WS_WBR); bf16* WoutT = (bf16*)(ws + WS_WOUT); bf16* WmemT = (bf16*)(ws + WS_WMEM);
    bf16* MK = (bf16*)(ws + WS_MK); bf16* MV = (bf16*)(ws + WS_MV); bf16* MN = (bf16*)(ws + WS_MN);
    bf16* H = (bf16*)(ws + WS_H); bf16* MG = H; bf16* OG = (bf16*)(ws + WS_OG);
    bf16* T1a = (bf16*)(ws + WS_T1); bf16* T1b = (bf16*)(ws + WS_T1 + 32 * MiB);
    bf16* DOa = (bf16*)p.out; bf16* DOb = (bf16*)((unsigned char*)p.out + 32 * MiB);
    const int lo = p.ph_lo, hi = p.ph_hi;
#ifndef PHASE_MASK
#define PHASE_MASK 0x3ff
#endif
#define IN(k) (((PHASE_MASK >> (k)) & 1) && lo <= (k) && (k) < hi)
#define SEAM(k) do { if (IN(k) && IN((k) + 1)) grid.sync(); } while (0)

    if (IN(0)) {
        LAS float* scr = (LAS float*)(lds + wave * 16384);
        const int gw = vcu * 8 + wave, NGW = G * 8;
        constexpr int I_IN = 16 * (INC / 32), I_BR = 3 * 16 * 32, I_OUT = 16 * 32, I_MEM = 16 * 64, NITEMS = I_IN + I_BR + I_OUT + I_MEM;
        for (int it = gw; it < NITEMS; it += NGW) {
            int r = it;
            if (r < I_IN) { const int nb = r % (INC / 32), kb = r / (INC / 32); p0_transpose_item(p.w_in, D, INC, WinT, win_dst_row(nb * 32), kb, nb * 32, scr, lane); continue; } r -= I_IN;
            if (r < I_BR) { const int b = r / 512, q = r % 512, nb = q % 32, kb = q / 32; p0_transpose_item(p.w_branch + (size_t)b * D * D, D, D, WbrT + (size_t)b * D * D, nb * 32, kb, nb * 32, scr, lane); continue; } r -= I_BR;
            if (r < I_OUT) { const int nb = r % 32, kb = r / 32; p0_transpose_item(p.w_out, D, D, WoutT, nb * 32, kb, nb * 32, scr, lane); continue; } r -= I_OUT;
            { const int nb = r % 64, kb = r / 64; p0_transpose_item(p.w_memkv, D, 2 * D, WmemT, nb * 32, kb, nb * 32, scr, lane); }
        }
        for (int m = gw; m < M_TOK; m += NGW) rms_row_to_bf16(p.x + (size_t)m * D, p.pre_norm, H + (size_t)m * D, lane);
        for (int m = gw; m < BATCH * NMEM; m += NGW) rms_row_to_bf16(p.mem + (size_t)m * D, p.mnorm, MN + (size_t)m * D, lane);
        if (bx == 0) {
            if (wave == 0) { float a = p.lq1[lane] * p.lk1[lane], b = p.lq2[lane] * p.lk2[lane]; a = wave_sum(a); b = wave_sum(b); if (lane == 0) TAB[0] = expf(a) - expf(b) + 0.2f; }
            for (int i = tid; i < 2048; i += 512) { const int dir = i >> 10, kc = i & 1023; const float a0 = p.lbl[dir * 2048 + kc], a1 = p.lbl[dir * 2048 + 1024 + kc];
                TAB[16 + i] = 1.0f / (1.0f + expf(a1 - a0)); }
        }
    }
    SEAM(0);
    if (IN(1)) {
        { pg8::Gemm g{H, WinT, M_TOK, 5120, D, D, D}; pg8::StaticOrder S; S.init(M_TOK, 5120, G, bx);
          pg8::EpiRoute<0> E{T1a, DOa, DOb, T1b, OG, 1024, 1024, 1024, 1024, 3072, 0, 0, 0, 0, 2048, 1.f, 1.f, 1.f, 1.f, 0.0625f * 1.4426950408889634f};
          pg8::gemm_phase<pg8::EpiRoute<0>, pg8::StaticOrder, true>(lds, g, S, E); }
        { pg8::Gemm g{MN, WmemT, BATCH * NMEM, 2048, D, D, D}; pg8::StaticOrder S; S.init(BATCH * NMEM, 2048, G, bx);
          pg8::EpiRoute<0> E{MK, MV, MV, MV, MV, 1024, 1024, 1024, 1024, 1024, 0, 0, 0, 0, 0, 1.f, 1.f, 1.f, 1.f, 1.f};
          pg8::gemm_phase<pg8::EpiRoute<0>, pg8::StaticOrder, true>(lds, g, S, E); }
    }
    SEAM(1);
#ifdef CHECK1
    {
        unsigned* ctl = (unsigned*)(ws + WS_TAB) + 8192;
        grid.sync();
        const size_t gt = (size_t)bx * 512 + tid, gs = (size_t)G * 512;
        for (size_t i = gt; i < (size_t)D * INC; i += gs) { const int k = (int)(i / INC), n = (int)(i % INC);
            const unsigned e = f2bf(p.w_in[i]); const unsigned a = WinT[(size_t)(win_dst_row(n & ~31) + (n & 31)) * D + k];
            if (e != a) atomicMax(ctl, 100u + (unsigned)(n >> 10)); }
        { const int gw = vcu * 8 + wave, NGW = G * 8;
          for (int m = gw; m < M_TOK; m += NGW) { const float* xr = p.x + (size_t)m * D; float s = 0.f; for (int j = lane; j < D; j += 64) s += xr[j] * xr[j];
              s = wave_sum(s); const float rstd = 1.0f / sqrtf(s * (1.f / 1024.f) + 1e-6f);
              for (int j = lane; j < D; j += 64) { const float e = xr[j] * rstd * p.pre_norm[j]; const float a = __uint_as_float(((unsigned)H[(size_t)m * D + j]) << 16);
                  if (fabsf(e - a) > 0.01f * fabsf(e) + 1e-3f) atomicMax(ctl, 200u); } } }
        for (size_t i = gt; i < (size_t)64 * 5120; i += gs) { const int sr = (int)(i / 5120), c = (int)(i % 5120); const int row = (sr < 4) ? (sr == 0 ? 0 : sr == 1 ? 255 : sr == 2 ? 256 : 16383) : (sr * 263 + 7) % M_TOK;
            float acc = 0.f; for (int k = 0; k < D; ++k) acc += __uint_as_float(((unsigned)H[(size_t)row * D + k]) << 16) * __uint_as_float(((unsigned)WinT[(size_t)c * D + k]) << 16);
            const int g = c >> 10, cw = c & 1023; float got;
            if (g == 0) got = __uint_as_float(((unsigned)T1a[(size_t)row * 1024 + cw]) << 16); else if (g == 1) got = __uint_as_float(((unsigned)DOa[(size_t)row * 1024 + cw]) << 16);
            else if (g == 2) got = __uint_as_float(((unsigned)DOb[(size_t)row * 1024 + cw]) << 16); else if (g == 3) got = __uint_as_float(((unsigned)T1b[(size_t)row * 1024 + cw]) << 16);
            else { got = __uint_as_float(((unsigned)OG[(size_t)row * 3072 + 2048 + cw]) << 16); acc *= 0.0625f * 1.4426950408889634f; }
            if (!(fabsf(acc - got) <= 0.02f * fabsf(acc) + 0.02f)) atomicMax(ctl, 300u + (unsigned)g); }
        grid.sync();
        const float code = (float)__hip_atomic_load(ctl, __ATOMIC_RELAXED, __HIP_MEMORY_SCOPE_AGENT);
        for (size_t i = gt; i < (size_t)M_TOK * D; i += gs) p.out[i] = (i == 0) ? (code == 0.f ? 777.f : code) : 0.f;
        return;
    }
#endif
    if (IN(2)) {
        const bool hg_cu = (G == 256) ? ((vcu & 3) == 0) : false;
        if (G == 256 && hg_cu) {
            const int u = vcu >> 2, dir = u & 1, bh = u >> 1;
            hg::Args a{T1a, dir ? DOb : DOa, T1b, 1024, OG, 3072, dir ? 0 : 1024, TAB + 16 + dir * 1024, bh >> 3, bh & 7, dir};
            HGRN_CALL(lds, a);
        } else {
            int ci, nc;
            if (G == 256) { ci = vcu - (vcu >> 2) - 1; nc = 192; } else { ci = bx; nc = G; }
#ifdef NAIVE_CROSS
            for (int it = ci * 8 + wave; it < M_TOK * 4; it += nc * 8) { const int row = it >> 2, head = it & 3, b = row >> 12;
                bf16* qo = OG + (size_t)row * 3072 + 2048 + head * 256;
                nv::cross_naive_row((LAS float*)lds + wave * 256, qo, MK + (size_t)b * NMEM * 1024 + head * 256, MV + (size_t)b * NMEM * 1024 + head * 256, qo, lane); }
#endif
            for (int u = ci; u < 512; u += nc) {
#ifdef NAIVE_CROSS
                break;
#endif
                const int b = u >> 7, head = (u >> 5) & 3, qblk = u & 31;
                fa::UnitArgs a{OG, 3072, 2048 + head * 256, 2048 + head * 256, (long)b * SEQ + qblk * 128, MK, 1024, head * 256, head * 256, MV, 1024, head * 256,
                               (long)b * NMEM, NMEM, OG, 3072, 2048 + head * 256, 0, nullptr, 0, 0.f, nullptr};
                fa::attn_unit<256, false>(lds, a);
            }
        }
        if (G != 256) { for (int u = bx; u < 64; u += G) { const int dir = u & 1, bh = u >> 1;
            hg::Args a{T1a, dir ? DOb : DOa, T1b, 1024, OG, 3072, dir ? 0 : 1024, TAB + 16 + dir * 1024, bh >> 3, bh & 7, dir}; HGRN_CALL(lds, a); } }
    }
    SEAM(2);
    if (IN(3)) {
        const int gw = vcu * 8 + wave, NGW = G * 8;
        for (int m = gw; m < M_TOK; m += NGW) {
            bf16* rowp = OG + (size_t)m * 3072;
            const v4u f0 = *(const v4u*)(rowp + 1024 + lane * 16), f1 = *(const v4u*)(rowp + 1024 + lane * 16 + 8);
            const v4u b0 = *(const v4u*)(rowp + lane * 16), b1 = *(const v4u*)(rowp + lane * 16 + 8);
            float v[16];
            const unsigned fw[8] = {f0.x, f0.y, f0.z, f0.w, f1.x, f1.y, f1.z, f1.w}, bw[8] = {b0.x, b0.y, b0.z, b0.w, b1.x, b1.y, b1.z, b1.w};
            float s = 0.f;
#pragma unroll
            for (int j = 0; j < 8; ++j) { v[2 * j] = __uint_as_float(fw[j] << 16) + __uint_as_float(bw[j] << 16); v[2 * j + 1] = __uint_as_float(fw[j] & 0xffff0000u) + __uint_as_float(bw[j] & 0xffff0000u);
                s += v[2 * j] * v[2 * j] + v[2 * j + 1] * v[2 * j + 1]; }
            s += __shfl_xor(s, 1); s += __shfl_xor(s, 2); s += __shfl_xor(s, 4);
            const float rstd = 1.0f / sqrtf(s * (1.f / 128.f) + 1e-6f);
            const float* hw = p.hnorm + (lane & 7) * 16;
            v4u o0, o1;
            o0.x = pk2(v[0] * rstd * hw[0], v[1] * rstd * hw[1]); o0.y = pk2(v[2] * rstd * hw[2], v[3] * rstd * hw[3]); o0.z = pk2(v[4] * rstd * hw[4], v[5] * rstd * hw[5]); o0.w = pk2(v[6] * rstd * hw[6], v[7] * rstd * hw[7]);
            o1.x = pk2(v[8] * rstd * hw[8], v[9] * rstd * hw[9]); o1.y = pk2(v[10] * rstd * hw[10], v[11] * rstd * hw[11]); o1.z = pk2(v[12] * rstd * hw[12], v[13] * rstd * hw[13]); o1.w = pk2(v[14] * rstd * hw[14], v[15] * rstd * hw[15]);
            *(v4u*)(rowp + 1024 + lane * 16) = o0; *(v4u*)(rowp + 1024 + lane * 16 + 8) = o1;
        }
    }
    SEAM(3);
    if (IN(4)) {
        pg8::Gemm g{H, WinT + (size_t)5120 * D, M_TOK, 3072, D, D, D}; pg8::StaticOrder S; S.init(M_TOK, 3072, G, bx);
        pg8::EpiRoute<0> E{OG, DOa, DOb, DOb, DOb, 3072, 1024, 1024, 1024, 1024, 0, 0, 0, 0, 0, 0.125f * 1.4426950408889634f, 1.f, 1.f, 1.f, 1.f};
        pg8::gemm_phase<pg8::EpiRoute<0>, pg8::StaticOrder, true>(lds, g, S, E);
    }
    SEAM(4);
    if (IN(5)) {
        const float lam = TAB[0];
#ifdef NAIVE_DIFF
        for (int it = vcu * 8 + wave; it < M_TOK * 8; it += G * 8) { const int h = it & 7, row = it >> 3, b = row >> 12, qpos = row & 4095;
            bf16* qo = OG + (size_t)row * 3072 + h * 128;
            nv::diff_naive_row((LAS float*)lds + wave * 4224, qo, qo + 64, DOa + (size_t)b * SEQ * 1024, h * 128, h * 128 + 64, DOb + (size_t)b * SEQ * 1024, h * 128, qpos, p.relb, h, lam, p.subln, qo, lane); }
#endif
        for (int u = vcu; u < 1024; u += G) {
#ifdef NAIVE_DIFF
            break;
#endif
            const int bh = u >> 5, qblk = u & 31, b = bh >> 3, h = bh & 7;
            fa::UnitArgs a{OG, 3072, h * 128, h * 128 + 64, (long)b * SEQ + qblk * 128, DOa, 1024, h * 128, h * 128 + 64, DOb, 1024, h * 128,
                           (long)b * SEQ, SEQ, OG, 3072, h * 128, qblk * 128, p.relb, h, lam, p.subln};
            fa::attn_unit<64, true>(lds, a);
        }
    }
    SEAM(5);
#ifdef CHECK2
#define SROW(sr) (((sr) < 4) ? ((sr) == 0 ? 0 : (sr) == 1 ? 255 : (sr) == 2 ? 256 : 16383) : ((sr) * 263 + 7) % M_TOK)
#define BF(v) __uint_as_float(((unsigned)(v)) << 16)
    unsigned* ctl = (unsigned*)(ws + WS_TAB) + 8192;
    bf16* SAVE = (bf16*)(ws + 240 * MiB);
    const size_t gt = (size_t)bx * 512 + tid, gs = (size_t)G * 512;
    for (size_t i = gt; i < (size_t)64 * 3072; i += gs) SAVE[i] = OG[(size_t)SROW((int)(i / 3072)) * 3072 + (i % 3072)];
    grid.sync();
#endif
    if (IN(6)) {
        { pg8::Gemm g{H, WinT + (size_t)8192 * D, M_TOK, 3072, D, D, D}; pg8::StaticOrder S; S.init(M_TOK, 3072, G, bx);
          pg8::EpiRoute<1> E{OG, OG, OG, OG, OG, 3072, 3072, 3072, 3072, 3072, 0, 1024, 2048, 0, 0, 1.f, 1.f, 1.f, 1.f, 1.f};
          pg8::gemm_phase<pg8::EpiRoute<1>, pg8::StaticOrder, true>(lds, g, S, E); }
        { pg8::Gemm g{H, WinT + (size_t)11264 * D, M_TOK, 3072, D, D, D}; pg8::StaticOrder S; S.init(M_TOK, 3072, G, bx);
          pg8::EpiRoute<2> E{DOa, DOb, T1a, T1a, T1a, 1024, 1024, 1024, 1024, 1024, 0, 0, 0, 0, 0, 1.f, 1.f, 1.f, 1.f, 1.f};
          pg8::gemm_phase<pg8::EpiRoute<2>, pg8::StaticOrder, true>(lds, g, S, E); }
    }
    SEAM(6);
#ifdef CHECK2
    grid.sync();
    for (size_t i = gt; i < (size_t)64 * 3072; i += gs) { const int sr = (int)(i / 3072), c = (int)(i % 3072), row = SROW(sr);
        float z = 0.f, gg = 0.f; for (int k = 0; k < D; ++k) { const float hv = BF(H[(size_t)row * D + k]); z += hv * BF(WinT[(size_t)(8192 + c) * D + k]); gg += hv * BF(WinT[(size_t)(11264 + c) * D + k]); }
        const float e1 = z / (1.0f + expf(-z)) * BF(SAVE[i]); const float a1 = BF(OG[(size_t)row * 3072 + c]);
        if (!(fabsf(e1 - a1) <= 0.03f * fabsf(e1) + 0.02f)) atomicMax(ctl, 600u + (unsigned)(c >> 10));
        const float e2 = 1.0f / (1.0f + expf(-gg)); const bf16* gb_ = (c < 1024) ? DOa : (c < 2048 ? DOb : T1a); const float a2 = BF(gb_[(size_t)row * 1024 + (c & 1023)]);
        if (!(fabsf(e2 - a2) <= 0.02f)) atomicMax(ctl, 650u + (unsigned)(c >> 10)); }
    grid.sync();
#endif
    if (IN(7)) {
        pg8::StaticOrder S; S.init(M_TOK, D, G, bx);
        { pg8::Gemm g{OG, WbrT, M_TOK, D, D, 3072, D}; pg8::EpiBranch<true> E{DOa, MG, 1024, 1024}; pg8::gemm_phase<pg8::EpiBranch<true>, pg8::StaticOrder, false>(lds, g, S, E); }
        { pg8::Gemm g{OG + 1024, WbrT + (size_t)D * D, M_TOK, D, D, 3072, D}; pg8::EpiBranch<false> E{DOb, MG, 1024, 1024}; pg8::gemm_phase<pg8::EpiBranch<false>, pg8::StaticOrder, false>(lds, g, S, E); }
        { pg8::Gemm g{OG + 2048, WbrT + (size_t)2 * D * D, M_TOK, D, D, 3072, D}; pg8::EpiBranch<false> E{T1a, MG, 1024, 1024}; pg8::gemm_phase<pg8::EpiBranch<false>, pg8::StaticOrder, false>(lds, g, S, E); }
    }
    SEAM(7);
#ifdef CHECK2
    grid.sync();
    for (size_t i = gt; i < (size_t)64 * 1024; i += gs) { const int sr = (int)(i / 1024), n = (int)(i % 1024), row = SROW(sr);
        float e = 0.f;
        for (int b = 0; b < 3; ++b) { float acc = 0.f; for (int k = 0; k < D; ++k) acc += BF(OG[(size_t)row * 3072 + b * 1024 + k]) * BF(WbrT[((size_t)b * D + n) * D + k]);
            const bf16* gb_ = (b == 0) ? DOa : (b == 1 ? DOb : T1a); e += acc * BF(gb_[(size_t)row * 1024 + n]); }
        const float a = BF(MG[(size_t)row * 1024 + n]);
        if (!(fabsf(e - a) <= 0.03f * fabsf(e) + 0.03f)) atomicMax(ctl, 500u); }
    grid.sync();
#endif
    if (IN(8)) {
        pg8::Gemm g{MG, WoutT, M_TOK, D, D, D, D}; pg8::StaticOrder S; S.init(M_TOK, D, G, bx);
        pg8::EpiF32 E{p.out, D};
        pg8::gemm_phase<pg8::EpiF32, pg8::StaticOrder, false>(lds, g, S, E);
    }
    SEAM(8);
    if (IN(9)) {
        const int gw = vcu * 8 + wave, NGW = G * 8;
        for (int m = gw; m < M_TOK; m += NGW) {
            f32x4v* yr = (f32x4v*)(p.out + (size_t)m * D) + lane; const f32x4v* xr = (const f32x4v*)(p.x + (size_t)m * D) + lane; const f32x4v* wr = (const f32x4v*)p.post_norm + lane;
            f32x4v v[4]; float s = 0.f;
#pragma unroll
            for (int j = 0; j < 4; ++j) { v[j] = yr[64 * j]; s += (v[j].x * v[j].x + v[j].y * v[j].y) + (v[j].z * v[j].z + v[j].w * v[j].w); }
            const float rstd = 1.0f / sqrtf(wave_sum(s) * (1.f / 1024.f) + 1e-6f);
#pragma unroll
            for (int j = 0; j < 4; ++j) yr[64 * j] = xr[64 * j] + v[j] * rstd * wr[64 * j];
        }
    }
#ifdef CHECK2
    grid.sync();
    { const int gw = vcu * 8 + wave, NGW = G * 8; LAS float* yb = (LAS float*)lds + wave * 1024;
      for (int sr = gw; sr < 64; sr += NGW) { const int row = SROW(sr); float ss = 0.f;
          for (int n = lane; n < D; n += 64) { float acc = 0.f; for (int k = 0; k < D; ++k) acc += BF(MG[(size_t)row * D + k]) * BF(WoutT[(size_t)n * D + k]); yb[n] = acc; ss += acc * acc; }
          ss = wave_sum(ss); const float rstd = 1.0f / sqrtf(ss * (1.f / 1024.f) + 1e-6f);
          for (int n = lane; n < D; n += 64) { const float e = p.x[(size_t)row * D + n] + yb[n] * rstd * p.post_norm[n]; const float a = p.out[(size_t)row * D + n];
              if (!(fabsf(e - a) <= 0.02f * fabsf(e) + 0.02f)) atomicMax(ctl, 400u); } } }
    grid.sync();
    { const float code = (float)__hip_atomic_load(ctl, __ATOMIC_RELAXED, __HIP_MEMORY_SCOPE_AGENT);
      for (size_t i = gt; i < (size_t)M_TOK * D; i += gs) p.out[i] = (i == 0) ? (code == 0.f ? 777.f : code) : 0.f; }
#endif
#undef IN
#undef SEAM
}

constexpr int N_PHASES = 10;
#ifndef MK_ONE_LAUNCH
#define MK_ONE_LAUNCH 1
#endif
extern "C" void kernel_launch(void* const* d_in, const int* in_sizes, int n_in, void* d_out, int out_size, void* d_ws, size_t ws_size, hipStream_t stream) {
    static int grid_blocks = 0;
    if (!grid_blocks) {
        int dev = 0, cus = 0, per_cu = 0;
        (void)hipGetDevice(&dev);
        (void)hipDeviceGetAttribute(&cus, hipDeviceAttributeMultiprocessorCount, dev);
        (void)hipFuncSetAttribute((const void*)fwd_kernel, hipFuncAttributeMaxDynamicSharedMemorySize, LDS_BYTES);
        (void)hipOccupancyMaxActiveBlocksPerMultiprocessor(&per_cu, (const void*)fwd_kernel, 512, LDS_BYTES);
        (void)hipGetLastError();
        grid_blocks = cus > 0 ? cus : 256;
        if (n_in != 17 || out_size != M_TOK * D || ws_size < WS_END) { fprintf(stderr, "kernel_launch: unexpected shapes\n"); }
    }
    (void)hipMemsetAsync((char*)d_ws + WS_TAB + 32768, 0, 256, stream);
    Params p{};
    p.x = (const float*)d_in[0]; p.mem = (const float*)d_in[1]; p.pre_norm = (const float*)d_in[2]; p.post_norm = (const float*)d_in[3]; p.w_in = (const float*)d_in[4];
    p.lq1 = (const float*)d_in[5]; p.lk1 = (const float*)d_in[6]; p.lq2 = (const float*)d_in[7]; p.lk2 = (const float*)d_in[8]; p.subln = (const float*)d_in[9];
    p.relb = (const float*)d_in[10]; p.lbl = (const float*)d_in[11]; p.hnorm = (const float*)d_in[12]; p.mnorm = (const float*)d_in[13]; p.w_memkv = (const float*)d_in[14];
    p.w_branch = (const float*)d_in[15]; p.w_out = (const float*)d_in[16];
    p.out = (float*)d_out; p.ws = (unsigned char*)d_ws;
#if MK_ONE_LAUNCH
    p.ph_lo = 0; p.ph_hi = N_PHASES;
    { void* args[] = {&p}; hipError_t e = hipLaunchCooperativeKernel((void*)fwd_kernel, dim3(grid_blocks), dim3(512), args, LDS_BYTES, stream);
      if (e != hipSuccess) fprintf(stderr, "cooperative launch failed: %s (grid %d)\n", hipGetErrorString(e), grid_blocks); }
#else
    for (int k = 0; k < N_PHASES; ++k) { p.ph_lo = k; p.ph_hi = k + 1; void* args[] = {&p};
        hipError_t e = hipLaunchCooperativeKernel((void*)fwd_kernel, dim3(grid_blocks), dim3(512), args, LDS_BYTES, stream);
        if (e != hipSuccess) { fprintf(stderr, "launch %d failed: %s\n", k, hipGetErrorString(e)); break; } }
#endif
}
```

```cpp
#include <hip/hip_runtime.h>
#include <hip/hip_cooperative_groups.h>
#include <cstdio>
#include <cstdint>
namespace cg = cooperative_groups;
#define GAS __attribute__((address_space(1)))
#define LAS __attribute__((address_space(3)))
typedef GAS unsigned gu32;
#define XB_TMO      128
#define XB_XCNT(j)  (256  + 64 * (j))
#define XB_XSUB(j)  (1280 + 64 * (j))
#define XB_XGEN(j)  (2304 + 64 * (j))
#define XB_TOP      3328
#define XB_TOPGEN   3392
#define XCD_BAR_WORDS 3456
#define XB_SPIN_CAP (1u << 18)
__device__ __forceinline__ unsigned xb_ld(unsigned* p)              { return __hip_atomic_load(p, __ATOMIC_RELAXED, __HIP_MEMORY_SCOPE_AGENT); }
__device__ __forceinline__ unsigned xb_add(unsigned* p, unsigned v) { return __hip_atomic_fetch_add(p, v, __ATOMIC_RELAXED, __HIP_MEMORY_SCOPE_AGENT); }
__device__ __forceinline__ unsigned xb_xcc_id() { return (unsigned)__builtin_amdgcn_s_getreg((3 << 11) | 20) & 0xFu; }
#define XB_SPIN(cond, bar) do { unsigned _sp = 0; while (cond) { __builtin_amdgcn_s_sleep(1); \
    if ((++_sp & 255u) == 0u) { if (xb_ld(&(bar)[XB_TMO])) break; if (_sp > XB_SPIN_CAP) { atomicAdd(&(bar)[XB_TMO], 1u); break; } } } } while (0)
struct XcdBarrier { unsigned* bar; unsigned x; volatile LAS unsigned* st; };
__device__ __forceinline__ XcdBarrier xcd_barrier_post(unsigned* bar, volatile LAS unsigned* st) {
    XcdBarrier b; b.bar = bar; b.x = xb_xcc_id(); b.st = st;
    if (threadIdx.x == 0) (void)xb_add(&bar[XB_XCNT(b.x)], 1u);
    return b;
}
__device__ __forceinline__ void xcd_barrier_complete(unsigned* bar, unsigned x, unsigned& nloc, unsigned& nx) {
    const unsigned G = gridDim.x * gridDim.y * gridDim.z;
    unsigned sum, cnt, mine, sp = 0u;
    for (;;) {
        sum = 0u; cnt = 0u; mine = 0u;
#pragma unroll
        for (unsigned j = 0; j < 16; ++j) { const unsigned c = xb_ld(&bar[XB_XCNT(j)]); sum += c; cnt += (c > 0u) ? 1u : 0u; mine = (j == x) ? c : mine; }
        if (sum == G) break;
        __builtin_amdgcn_s_sleep(1);
        if ((++sp & 255u) == 0u) { if (xb_ld(&bar[XB_TMO])) break; if (sp > XB_SPIN_CAP) { atomicAdd(&bar[XB_TMO], 1u); break; } }
    }
    nloc = mine > 0u ? mine : 1u; nx = cnt > 0u ? cnt : 1u;
}
__device__ __forceinline__ void xcd_barrier(const XcdBarrier& b) {
    asm volatile("s_waitcnt vmcnt(0)" ::: "memory");
    __syncthreads();
    if (threadIdx.x == 0) {
        unsigned* bar = b.bar;
        __builtin_amdgcn_s_waitcnt(0);
        unsigned nloc = b.st[0], nx = b.st[1];
        if (nloc == 0u) { xcd_barrier_complete(bar, b.x, nloc, nx); b.st[0] = nloc; b.st[1] = nx; }
        const unsigned old = xb_add(&bar[XB_XSUB(b.x)], 1u);
        const unsigned gen = old / nloc;
        if (old + 1u == (gen + 1u) * nloc) {
            __builtin_amdgcn_fence(__ATOMIC_RELEASE, "agent");
            asm volatile("s_waitcnt vmcnt(0)" ::: "memory");
            const unsigned og = xb_add(&bar[XB_TOP], 1u);
            const unsigned tg = og / nx;
            if (og + 1u == (tg + 1u) * nx) xb_add(&bar[XB_TOPGEN], 1u);
            else XB_SPIN(xb_ld(&bar[XB_TOPGEN]) == tg, bar);
            __builtin_amdgcn_fence(__ATOMIC_ACQUIRE, "agent");
            xb_add(&bar[XB_XGEN(b.x)], 1u);
            asm volatile("s_waitcnt vmcnt(0)" ::: "memory");
        } else {
            XB_SPIN(xb_ld(&bar[XB_XGEN(b.x)]) == gen, bar);
            __builtin_amdgcn_fence(__ATOMIC_ACQUIRE, "agent");
            asm volatile("s_waitcnt vmcnt(0)" ::: "memory");
        }
    }
    __syncthreads();
}
namespace pg8 {
#define PG8_LAS __attribute__((address_space(3)))
typedef unsigned short bf16_t;
typedef short bf16x8 __attribute__((ext_vector_type(8)));
typedef float f32x4 __attribute__((ext_vector_type(4)));
typedef unsigned u32x4 __attribute__((ext_vector_type(4)));
constexpr int BM = 256, BK = 64, HALF = 128, HTB = HALF * BK * 2, STAGE_BYTES = 8 * HTB, NXCD = 8, WGM = 8;

__host__ __device__ __forceinline__ int lds_byte(int r, int c) { const int st = (r >> 4) * 2 + (c >> 5), rr = r & 15, cc = c & 31, ob = rr * 64 + cc * 2; return st * 1024 + (ob ^ (((ob >> 9) & 1) << 5)); }
__host__ __device__ __forceinline__ void stage_rc(int b, int& R, int& C) { const int st = b / 1024, sb = b % 1024, swz = sb ^ (((sb >> 9) & 1) << 5); R = (st >> 1) * 16 + swz / 64; C = (st & 1) * 32 + (swz % 64) / 2; }
__host__ __device__ __forceinline__ int perm32(int rho) { const int n = rho >> 4, i = rho & 15; return 8 * (i >> 2) + 4 * n + (i & 3); }

struct Unit { int pm, pn; };
struct Gemm { const bf16_t* A; const bf16_t* Bt; int M, N, K, lda, ldb; };

struct StaticOrder {
    int nM, nN, nwg, G, c;
    __host__ __device__ void init(int M, int N, int G_, int c_) { nM = M / BM; nN = N / BM; nwg = nM * nN; G = G_; c = c_; }
    __host__ __device__ bool next(int i, Unit& u) const {
        const long L = (long)i * G + c; if (L >= nwg) return false;
        int wgid = (int)L; { const int q = nwg / NXCD, r = nwg % NXCD, xcd = wgid % NXCD, off = wgid / NXCD; wgid = (xcd < r ? xcd * (q + 1) : r * (q + 1) + (xcd - r) * q) + off; }
        const int nig = WGM * nN, gid = wgid / nig, fm = gid * WGM, gsz = (nM - fm) < WGM ? (nM - fm) : WGM;
        u.pm = fm + ((wgid % nig) % gsz); u.pn = (wgid % nig) / gsz; return true;
    }
    __device__ __forceinline__ void a_ready(const Unit&) const {}
    __device__ __forceinline__ void done(const Unit&) const {}
};

typedef float f32x2_t __attribute__((ext_vector_type(2))); typedef __bf16 bf16x2_t __attribute__((ext_vector_type(2)));
__device__ __forceinline__ unsigned cvt_pk_bf16(float lo, float hi) { f32x2_t v = {lo, hi}; bf16x2_t b = __builtin_convertvector(v, bf16x2_t); return __builtin_bit_cast(unsigned, b); }
__device__ __forceinline__ float bf_lo(unsigned w) { return __uint_as_float(w << 16); }
__device__ __forceinline__ float bf_hi(unsigned w) { return __uint_as_float(w & 0xffff0000u); }
__device__ __forceinline__ float fsigmoid(float v) { return __builtin_amdgcn_rcpf(1.0f + __builtin_amdgcn_exp2f(-1.4426950408889634f * v)); }

template <int MODE> struct EpiRoute {
    static constexpr bool PERM = true, AFTER_DRAIN = false;
    bf16_t *b0, *b1, *b2, *b3, *b4; int l0, l1, l2, l3, l4; int c0, c1, c2, c3, c4; float s0, s1, s2, s3, s4;
    __device__ __forceinline__ void operator()(const f32x4 (&acc)[2][2][4][2], const Unit& u, int wr, int wc, int fr, int fq) const {
        const int row0 = u.pm * BM + wr * 64 + fr; const int colt = u.pn * BM; const int g = colt >> 10, cw = colt & 1023;
        bf16_t* base = g == 0 ? b0 : g == 1 ? b1 : g == 2 ? b2 : g == 3 ? b3 : b4;
        const int ldc = g == 0 ? l0 : g == 1 ? l1 : g == 2 ? l2 : g == 3 ? l3 : l4;
        const int cof = g == 0 ? c0 : g == 1 ? c1 : g == 2 ? c2 : g == 3 ? c3 : c4;
        const float sc = g == 0 ? s0 : g == 1 ? s1 : g == 2 ? s2 : g == 3 ? s3 : s4;
        const int col0 = cof + cw + wc * 32 + 8 * fq;
#pragma unroll
        for (int ai = 0; ai < 2; ++ai)
#pragma unroll
            for (int m = 0; m < 4; ++m) { bf16_t* rowp = base + (size_t)(row0 + ai * HALF + m * 16) * ldc + col0;
#pragma unroll
                for (int bj = 0; bj < 2; ++bj) { f32x4 v0 = acc[ai][bj][m][0], v1 = acc[ai][bj][m][1];
                    if (MODE == 0) { v0 = v0 * sc; v1 = v1 * sc; }
                    if (MODE == 1) { const u32x4 o = *(const u32x4*)(rowp + bj * HALF);
#pragma unroll
                        for (int e = 0; e < 4; ++e) { v0[e] = v0[e] * fsigmoid(v0[e]); v1[e] = v1[e] * fsigmoid(v1[e]); }
                        v0[0] *= bf_lo(o.x); v0[1] *= bf_hi(o.x); v0[2] *= bf_lo(o.y); v0[3] *= bf_hi(o.y);
                        v1[0] *= bf_lo(o.z); v1[1] *= bf_hi(o.z); v1[2] *= bf_lo(o.w); v1[3] *= bf_hi(o.w); }
                    if (MODE == 2) {
#pragma unroll
                        for (int e = 0; e < 4; ++e) { v0[e] = fsigmoid(v0[e]); v1[e] = fsigmoid(v1[e]); } }
                    u32x4 w; w.x = cvt_pk_bf16(v0[0], v0[1]); w.y = cvt_pk_bf16(v0[2], v0[3]); w.z = cvt_pk_bf16(v1[0], v1[1]); w.w = cvt_pk_bf16(v1[2], v1[3]);
                    *(u32x4*)(rowp + bj * HALF) = w; } }
    }
};
template <bool FIRST> struct EpiBranch {
    static constexpr bool PERM = true, AFTER_DRAIN = false;
    const bf16_t* gate; bf16_t* mg; int ldg, ldc;
    __device__ __forceinline__ void operator()(const f32x4 (&acc)[2][2][4][2], const Unit& u, int wr, int wc, int fr, int fq) const {
        const int row0 = u.pm * BM + wr * 64 + fr; const int col0 = u.pn * BM + wc * 32 + 8 * fq;
#pragma unroll
        for (int ai = 0; ai < 2; ++ai)
#pragma unroll
            for (int m = 0; m < 4; ++m) { const size_t r = (size_t)(row0 + ai * HALF + m * 16);
#pragma unroll
                for (int bj = 0; bj < 2; ++bj) { f32x4 v0 = acc[ai][bj][m][0], v1 = acc[ai][bj][m][1];
                    const u32x4 g = *(const u32x4*)(gate + r * ldg + col0 + bj * HALF);
                    v0[0] *= bf_lo(g.x); v0[1] *= bf_hi(g.x); v0[2] *= bf_lo(g.y); v0[3] *= bf_hi(g.y);
                    v1[0] *= bf_lo(g.z); v1[1] *= bf_hi(g.z); v1[2] *= bf_lo(g.w); v1[3] *= bf_hi(g.w);
                    bf16_t* p = mg + r * ldc + col0 + bj * HALF;
                    if (!FIRST) { const u32x4 o = *(const u32x4*)p;
                        v0[0] += bf_lo(o.x); v0[1] += bf_hi(o.x); v0[2] += bf_lo(o.y); v0[3] += bf_hi(o.y);
                        v1[0] += bf_lo(o.z); v1[1] += bf_hi(o.z); v1[2] += bf_lo(o.w); v1[3] += bf_hi(o.w); }
                    u32x4 w; w.x = cvt_pk_bf16(v0[0], v0[1]); w.y = cvt_pk_bf16(v0[2], v0[3]); w.z = cvt_pk_bf16(v1[0], v1[1]); w.w = cvt_pk_bf16(v1[2], v1[3]);
                    *(u32x4*)p = w; } }
    }
};
struct EpiF32 {
    static constexpr bool PERM = false, AFTER_DRAIN = false;
    float* out; int ldc;
    __device__ __forceinline__ void operator()(const f32x4 (&acc)[2][2][4][2], const Unit& u, int wr, int wc, int fr, int fq) const {
        const int col0 = u.pn * BM + wc * 32 + 4 * fq;
#pragma unroll
        for (int ai = 0; ai < 2; ++ai)
#pragma unroll
            for (int m = 0; m < 4; ++m) { const size_t off = (size_t)(u.pm * BM + ai * HALF + wr * 64 + m * 16 + fr) * ldc + col0;
#pragma unroll
                for (int bj = 0; bj < 2; ++bj)
#pragma unroll
                    for (int n = 0; n < 2; ++n) *(f32x4*)(out + off + bj * HALF + n * 16) = acc[ai][bj][m][n]; }
    }
};

template <class Epi, class Sched, bool ALIGN_EPI>
__device__ __forceinline__ void gemm_phase(PG8_LAS unsigned char* lds, const Gemm g, const Sched& S, const Epi& E) {
    const int tid = threadIdx.x, wid = __builtin_amdgcn_readfirstlane(tid >> 6), lane = tid & 63, wr = wid >> 2, wc = wid & 3, fr = lane & 15, fq = lane >> 4;
    const int K = g.K, nt = K / BK;
    unsigned voffA[2], voffB[2];
#pragma unroll
    for (int i = 0; i < 2; ++i) { int R, C; stage_rc(tid * 16 + i * 8192, R, C); const int Rb = Epi::PERM ? ((R & ~31) + perm32(R & 31)) : R;
        voffA[i] = (unsigned)(R * g.lda + C) * 2u; voffB[i] = (unsigned)(Rb * g.ldb + C) * 2u; }
    const size_t kstep = (size_t)(BK * 2);
    const size_t hstepA = (size_t)HALF * g.lda * 2, hstepB = (size_t)HALF * g.ldb * 2;
    const size_t tstepA = 2 * hstepA, tstepB = 2 * hstepB;
    const unsigned ldsw = (unsigned)wid * 1024u;
    const int aoff = lds_byte(wr * 64 + fr, fq * 8), boff = lds_byte(wc * 32 + fr, fq * 8);
#define PG8_SA(b, h) (((b) * 2 + (h)) * HTB)
#define PG8_SB(b, h) ((4 + (b) * 2 + (h)) * HTB)
#define PG8_STAGE(bufoff, gbase, voff) do { _Pragma("unroll") for (int _i = 0; _i < 2; ++_i) \
        __builtin_amdgcn_global_load_lds((const unsigned*)((const char*)(gbase) + (voff)[_i]), (PG8_LAS unsigned*)(lds + (bufoff) + ldsw + _i * 8192), 16, 0, 0); } while (0)
#define PG8_LDA(dst, b, h) do { _Pragma("unroll") for (int m = 0; m < 4; ++m) _Pragma("unroll") for (int k = 0; k < 2; ++k) dst[m][k] = *(const PG8_LAS bf16x8*)(lds + PG8_SA(b, h) + aoff + m * 2048 + k * 1024); } while (0)
#define PG8_LDB(dst, b, h) do { _Pragma("unroll") for (int n = 0; n < 2; ++n) _Pragma("unroll") for (int k = 0; k < 2; ++k) dst[n][k] = *(const PG8_LAS bf16x8*)(lds + PG8_SB(b, h) + boff + n * 2048 + k * 1024); } while (0)
#define PG8_MMA(ai, bj, At, Bt) do { __builtin_amdgcn_s_setprio(1); _Pragma("unroll") for (int m = 0; m < 4; ++m) _Pragma("unroll") for (int n = 0; n < 2; ++n) _Pragma("unroll") for (int k = 0; k < 2; ++k) \
        acc[ai][bj][m][n] = __builtin_amdgcn_mfma_f32_16x16x32_bf16(Bt[n][k], At[m][k], acc[ai][bj][m][n], 0, 0, 0); __builtin_amdgcn_s_setprio(0); } while (0)
#define PG8_WAIT_V(n) asm volatile("s_waitcnt vmcnt(" #n ")" ::: "memory")
#define PG8_WAIT_L(n) asm volatile("s_waitcnt lgkmcnt(" #n ")" ::: "memory")
#define PG8_BAR __builtin_amdgcn_s_barrier()
#define PG8_SCHED __builtin_amdgcn_sched_barrier(0)
    Unit cur, nxt; int ui = 0;
    if (!S.next(0, cur)) return;
    f32x4 acc[2][2][4][2];
#pragma unroll
    for (int a = 0; a < 2; ++a)
#pragma unroll
        for (int b = 0; b < 2; ++b)
#pragma unroll
            for (int m = 0; m < 4; ++m)
#pragma unroll
                for (int n = 0; n < 2; ++n) acc[a][b][m][n] = (f32x4){0.f, 0.f, 0.f, 0.f};
    bf16x8 At[4][2], B0[2][2], B1[2][2];
    const char* cA = (const char*)g.A + (size_t)cur.pm * tstepA; const char* cB = (const char*)g.Bt + (size_t)cur.pn * tstepB;
    S.a_ready(cur);
    PG8_STAGE(PG8_SB(0, 0), cB, voffB); PG8_STAGE(PG8_SB(0, 1), cB + hstepB, voffB); PG8_STAGE(PG8_SA(0, 0), cA, voffA); PG8_STAGE(PG8_SA(0, 1), cA + hstepA, voffA);
    if (wr == 1) PG8_BAR;
    PG8_WAIT_V(2); PG8_BAR;
    PG8_STAGE(PG8_SB(1, 0), cB + kstep, voffB); PG8_STAGE(PG8_SA(1, 0), cA + kstep, voffA); PG8_STAGE(PG8_SB(1, 1), cB + hstepB + kstep, voffB);
    PG8_WAIT_V(6); PG8_BAR;
    for (;;) {
        const bool has_next = S.next(ui + 1, nxt);
        const char* nA = has_next ? (const char*)g.A + (size_t)nxt.pm * tstepA : cA; const char* nB = has_next ? (const char*)g.Bt + (size_t)nxt.pn * tstepB : cB;
        for (int t = 0; t < nt; t += 2) {
            const bool last = (t == nt - 2);
            const char* a1 = cA + (size_t)(t + 1) * kstep;
            const char* a2 = last ? nA : cA + (size_t)(t + 2) * kstep; const char* b2 = last ? nB : cB + (size_t)(t + 2) * kstep;
            const char* a3 = a2 + kstep; const char* b3 = b2 + kstep;
            if (last && has_next) S.a_ready(nxt);
            PG8_LDB(B0, 0, 0); PG8_LDB(B1, 0, 1); PG8_SCHED; PG8_LDA(At, 0, 0); PG8_STAGE(PG8_SA(1, 1), a1 + hstepA, voffA);
            PG8_WAIT_V(8); PG8_WAIT_L(0); PG8_BAR; PG8_MMA(0, 0, At, B0); PG8_MMA(0, 1, At, B1); PG8_BAR; PG8_SCHED;
            PG8_LDA(At, 0, 1); PG8_STAGE(PG8_SB(0, 0), b2, voffB); PG8_STAGE(PG8_SB(0, 1), b2 + hstepB, voffB); PG8_STAGE(PG8_SA(0, 0), a2, voffA);
            PG8_WAIT_V(8); PG8_WAIT_L(0); PG8_BAR; PG8_MMA(1, 0, At, B0); PG8_MMA(1, 1, At, B1); PG8_BAR; PG8_SCHED;
            PG8_LDB(B0, 1, 0); PG8_LDB(B1, 1, 1); PG8_SCHED; PG8_LDA(At, 1, 0); PG8_STAGE(PG8_SA(0, 1), a2 + hstepA, voffA);
            PG8_WAIT_V(8); PG8_WAIT_L(0); PG8_BAR; PG8_MMA(0, 0, At, B0); PG8_MMA(0, 1, At, B1); PG8_BAR; PG8_SCHED;
            PG8_LDA(At, 1, 1); PG8_STAGE(PG8_SB(1, 0), b3, voffB); PG8_STAGE(PG8_SB(1, 1), b3 + hstepB, voffB); PG8_STAGE(PG8_SA(1, 0), a3, voffA);
            PG8_WAIT_V(8); PG8_WAIT_L(0); PG8_BAR; PG8_MMA(1, 0, At, B0); PG8_MMA(1, 1, At, B1); PG8_BAR; PG8_SCHED;
        }
        if constexpr (ALIGN_EPI) { if (wr == 0) PG8_BAR; }
        E(acc, cur, wr, wc, fr, fq); S.done(cur);
        if (!has_next) break;
#pragma unroll
        for (int a = 0; a < 2; ++a)
#pragma unroll
            for (int b = 0; b < 2; ++b)
#pragma unroll
                for (int m = 0; m < 4; ++m)
#pragma unroll
                    for (int n = 0; n < 2; ++n) acc[a][b][m][n] = (f32x4){0.f, 0.f, 0.f, 0.f};
        cur = nxt; cA = nA; cB = nB; ++ui;
        if constexpr (ALIGN_EPI) { if (wr == 1) PG8_BAR; }
    }
    PG8_WAIT_V(0);
    if constexpr (!ALIGN_EPI) { if (wr == 0) PG8_BAR; }
    PG8_BAR;
#undef PG8_SA
#undef PG8_SB
#undef PG8_STAGE
#undef PG8_LDA
#undef PG8_LDB
#undef PG8_MMA
#undef PG8_WAIT_V
#undef PG8_WAIT_L
#undef PG8_BAR
#undef PG8_SCHED
}
}
namespace fa {
#define FA_LAS __attribute__((address_space(3)))
typedef unsigned short bf16_t;
typedef short bf16x8 __attribute__((ext_vector_type(8)));
typedef short s16x4 __attribute__((ext_vector_type(4)));
typedef float f32x16 __attribute__((ext_vector_type(16)));
typedef unsigned u32x4 __attribute__((ext_vector_type(4)));
typedef float f32x2_t __attribute__((ext_vector_type(2)));
typedef __bf16 bf16x2_t __attribute__((ext_vector_type(2)));
typedef FA_LAS unsigned char lds_u8;
#define DI __device__ __forceinline__
DI int crow(int r, int hi) { return (r & 3) + 8 * (r >> 2) + 4 * hi; }
DI unsigned cvtpk(float lo, float hi) { f32x2_t v = {lo, hi}; bf16x2_t b = __builtin_convertvector(v, bf16x2_t); return __builtin_bit_cast(unsigned, b); }
DI s16x4 vtr(const lds_u8* p) { return __builtin_bit_cast(s16x4, __builtin_amdgcn_ds_read_tr16_b64_v4i16((FA_LAS s16x4*)p)); }
DI bf16x8 frag_rm(const lds_u8* base, int row, int ch, int rowbytes) { return *(const FA_LAS bf16x8*)(base + row * rowbytes + (ch << 4)); }
DI f32x16 splat16(float v) { f32x16 r; _Pragma("unroll") for (int i = 0; i < 16; ++i) r[i] = v; return r; }
DI float rowmax32(const f32x16& a, const f32x16& b) {
    float m = fmaxf(a[0], b[0]);
#pragma unroll
    for (int r = 1; r < 16; ++r) m = fmaxf(m, fmaxf(a[r], b[r]));
    return fmaxf(m, __shfl_xor(m, 32));
}
DI int t5_bucket(int rel) { const int n = rel < 0 ? -rel : rel; int b; if (n < 8) b = n; else { const int l2 = 31 - __builtin_clz((unsigned)(n * n)); b = 2 + l2; if (b > 15) b = 15; } return b + (rel > 0 ? 16 : 0); }

constexpr float LOG2E = 1.4426950408889634f;
constexpr int RB = 192;

template <int DQK, bool DIFF> struct Cfg {
    static constexpr int NCH = DQK / 8, KROWB = DQK * 2 + 16, NKV = DIFF ? 2 : 1, KT_BYTES = 64 * KROWB,
                         NVB = DIFF ? 4 : 8, V_BYTES = NVB * 4096, STAGE = NKV * KT_BYTES + V_BYTES,
                         KREG = NKV * 64 * NCH / 512, VREG = NVB * 256 / 512, NDS = DQK / 16;
    static constexpr int OFF_WSF = 2 * STAGE, OFF_TAB = OFF_WSF + 8 * 128, OFF_X = 0;
};

struct UnitArgs {
    const bf16_t* Q; int qpitch; int qcol0, qcol1; long qrow0;
    const bf16_t* K; int kpitch; int kcol0, kcol1;
    const bf16_t* V; int vpitch; int vcol0;
    long krow0; int nkeys;
    bf16_t* O; int opitch; int ocol;
    int qpos0;
    const float* relb; int head;
    float lam; const float* subw;
};

template <int DQK, bool DIFF>
DI void attn_unit(lds_u8* lds, const UnitArgs& a) {
    typedef Cfg<DQK, DIFF> C;
    const int tid = threadIdx.x, lane = tid & 63, r32 = lane & 31, hi = lane >> 5;
    const int wid = __builtin_amdgcn_readfirstlane(tid >> 6), qb = wid & 3, var = wid >> 2;
    volatile FA_LAS float* wsf = (volatile FA_LAS float*)(lds + C::OFF_WSF) + wid * 32;
    FA_LAS float* tab = (FA_LAS float*)(lds + C::OFF_TAB);
    const int NT = a.nkeys / 64;
    constexpr int NQF = DIFF ? C::NDS : 1;
    bf16x8 qf[NQF];
    const bf16_t* qp = a.Q + (a.qrow0 + qb * 32 + r32) * (long)a.qpitch + (var ? a.qcol1 : a.qcol0) + hi * 8;
    if (DIFF) {
#pragma unroll
      for (int ds = 0; ds < NQF; ++ds) qf[ds] = *(const bf16x8*)(qp + ds * 16); }
    if (DIFF) { for (int i = tid; i < 2 * RB + 1; i += 512) tab[i] = a.relb[t5_bucket(i - RB) * 8 + a.head] * LOG2E; }
    float bcl = 0.f, bcr = 0.f;
    if (DIFF) { bcl = a.relb[15 * 8 + a.head] * LOG2E; bcr = a.relb[31 * 8 + a.head] * LOG2E; }
    u32x4 kreg[C::KREG], vreg[C::VREG];
#define FA_GLOAD(t) do { \
      _Pragma("unroll") for (int i = 0; i < C::KREG; ++i) { const int pid = tid + 512 * i, kv = pid / (64 * C::NCH), rem = pid % (64 * C::NCH), key = rem / C::NCH, ch = rem % C::NCH; \
          kreg[i] = *(const u32x4*)(a.K + (a.krow0 + (long)(t) * 64 + key) * a.kpitch + (kv ? a.kcol1 : a.kcol0) + ch * 8); } \
      _Pragma("unroll") for (int i = 0; i < C::VREG; ++i) { const int pid = tid + 512 * i, piece = pid >> 6, l6 = pid & 63, key = 16 * (piece & 3) + (l6 >> 2), col = (piece >> 2) * 32 + (l6 & 3) * 8; \
          vreg[i] = *(const u32x4*)(a.V + (a.krow0 + (long)(t) * 64 + key) * a.vpitch + a.vcol0 + col); } } while (0)
#define FA_LSTORE(buf) do { lds_u8* sb_ = lds + (buf) * C::STAGE; \
      _Pragma("unroll") for (int i = 0; i < C::KREG; ++i) { const int pid = tid + 512 * i, kv = pid / (64 * C::NCH), rem = pid % (64 * C::NCH), key = rem / C::NCH, ch = rem % C::NCH; \
          *(FA_LAS u32x4*)(sb_ + kv * C::KT_BYTES + key * C::KROWB + (ch << 4)) = kreg[i]; } \
      _Pragma("unroll") for (int i = 0; i < C::VREG; ++i) { const int pid = tid + 512 * i; *(FA_LAS u32x4*)(sb_ + C::NKV * C::KT_BYTES + pid * 16) = vreg[i]; } } while (0)
    FA_GLOAD(0); FA_LSTORE(0);
    __syncthreads();
    float mhat = 0.f, lsum = 0.f;
    f32x16 o[4];
#pragma unroll
    for (int d0 = 0; d0 < 4; ++d0) o[d0] = splat16(0.f);
    const int qpw = a.qpos0 + qb * 32;
    const int vlane = ((lane >> 4) & 1) * 32 + (lane & 3) * 8 + (4 * hi + ((lane & 15) >> 2)) * 64;
    for (int t = 0; t < NT; ++t) {
        const int buf = t & 1;
        if (DIFF && t + 1 < NT) FA_GLOAD(t + 1);
        const lds_u8* sb = lds + buf * C::STAGE;
        const lds_u8* kb = sb + (DIFF ? var : 0) * C::KT_BYTES;
        int bmode = 0; float cini = -mhat;
        if (DIFF) { const int k0 = t * 64; if (k0 + 63 <= qpw - 91) cini += bcl; else if (k0 >= qpw + 31 + 91) cini += bcr; else bmode = 1; }
        f32x16 c0 = splat16(cini), c1 = c0;
        const bf16_t* qpt = qp; if (!DIFF) asm volatile("" : "+v"(qpt));
#pragma unroll
        for (int ds = 0; ds < C::NDS; ++ds) {
            const bf16x8 a0 = frag_rm(kb, r32, 2 * ds + hi, C::KROWB), a1 = frag_rm(kb, 32 + r32, 2 * ds + hi, C::KROWB);
            bf16x8 qv; if (DIFF) qv = qf[DIFF ? ds : 0]; else qv = *(const bf16x8*)(qpt + ds * 16);
            c0 = __builtin_amdgcn_mfma_f32_32x32x16_bf16(a0, qv, c0, 0, 0, 0);
            c1 = __builtin_amdgcn_mfma_f32_32x32x16_bf16(a1, qv, c1, 0, 0, 0);
        }
        if (DIFF && bmode) {
            const int relb0 = t * 64 - (qpw + r32) + RB;
#pragma unroll
            for (int r = 0; r < 16; ++r) { int i0 = relb0 + crow(r, hi), i1 = i0 + 32; i0 = i0 < 0 ? 0 : (i0 > 2 * RB ? 2 * RB : i0); i1 = i1 < 0 ? 0 : (i1 > 2 * RB ? 2 * RB : i1);
                c0[r] += tab[i0]; c1[r] += tab[i1]; }
        }
        const float rm = rowmax32(c0, c1);
        const bool need = (t == 0) || __any(rm > 6.0f);
        if (need) {
            const float dl = (t == 0) ? rm : fmaxf(rm, 0.f);
            mhat += dl;
#pragma unroll
            for (int r = 0; r < 16; ++r) { c0[r] -= dl; c1[r] -= dl; }
            if (t != 0) {
                const float f = __builtin_amdgcn_exp2f(-dl); lsum *= f;
                if (hi == 0) wsf[r32] = f;
                float fr[16];
#pragma unroll
                for (int r = 0; r < 16; ++r) fr[r] = wsf[crow(r, hi)];
#pragma unroll
                for (int d0 = 0; d0 < 4; ++d0)
#pragma unroll
                    for (int r = 0; r < 16; ++r) o[d0][r] *= fr[r];
            }
        }
        float ps = 0.f;
#pragma unroll
        for (int r = 0; r < 16; ++r) { c0[r] = __builtin_amdgcn_exp2f(c0[r]); c1[r] = __builtin_amdgcn_exp2f(c1[r]); ps += c0[r] + c1[r]; }
        lsum += ps;
        u32x4 pw[4];
#pragma unroll
        for (int j = 0; j < 4; ++j) { pw[0][j] = cvtpk(c0[2 * j], c0[2 * j + 1]); pw[1][j] = cvtpk(c0[8 + 2 * j], c0[9 + 2 * j]); pw[2][j] = cvtpk(c1[2 * j], c1[2 * j + 1]); pw[3][j] = cvtpk(c1[8 + 2 * j], c1[9 + 2 * j]); }
        const lds_u8* vb = sb + C::NKV * C::KT_BYTES + (DIFF ? 0 : var * 4 * 4096) + vlane;
#pragma unroll
        for (int d0 = 0; d0 < 4; ++d0) {
#pragma unroll
            for (int ks = 0; ks < 4; ++ks) {
                const s16x4 lo = vtr(vb + d0 * 4096 + ks * 1024), hh = vtr(vb + d0 * 4096 + ks * 1024 + 512);
                const bf16x8 vf = (bf16x8){lo[0], lo[1], lo[2], lo[3], hh[0], hh[1], hh[2], hh[3]};
                o[d0] = __builtin_amdgcn_mfma_f32_32x32x16_bf16(__builtin_bit_cast(bf16x8, pw[ks]), vf, o[d0], 0, 0, 0);
            }
        }
        if (!DIFF && t + 1 < NT) FA_GLOAD(t + 1);
        if (t + 1 < NT) FA_LSTORE(buf ^ 1);
        __syncthreads();
    }
#undef FA_GLOAD
#undef FA_LSTORE
    const float ltot = lsum + __shfl_xor(lsum, 32);
    const float inv = (DIFF && var) ? a.lam / ltot : 1.0f / ltot;
    if (hi == 0) wsf[r32] = inv;
    float fr[16];
#pragma unroll
    for (int r = 0; r < 16; ++r) fr[r] = wsf[crow(r, hi)];
    if (DIFF) {
        FA_LAS float* X = (FA_LAS float*)(lds + C::OFF_X);
        if (var == 1) {
#pragma unroll
            for (int d0 = 0; d0 < 4; ++d0)
#pragma unroll
                for (int r = 0; r < 16; ++r) X[(qb * 32 + crow(r, hi)) * 128 + d0 * 32 + r32] = o[d0][r] * fr[r];
        }
        __syncthreads();
        if (var == 0) {
            float ss[16];
#pragma unroll
            for (int r = 0; r < 16; ++r) ss[r] = 0.f;
#pragma unroll
            for (int d0 = 0; d0 < 4; ++d0)
#pragma unroll
                for (int r = 0; r < 16; ++r) { const float d = o[d0][r] * fr[r] - X[(qb * 32 + crow(r, hi)) * 128 + d0 * 32 + r32]; o[d0][r] = d; ss[r] += d * d; }
#pragma unroll
            for (int r = 0; r < 16; ++r) { float s = ss[r]; s += __shfl_xor(s, 1); s += __shfl_xor(s, 2); s += __shfl_xor(s, 4); s += __shfl_xor(s, 8); s += __shfl_xor(s, 16);
                ss[r] = __builtin_amdgcn_rsqf(s * (1.0f / 128.0f) + 1e-6f) * 0.8f; }
#pragma unroll
            for (int d0 = 0; d0 < 4; ++d0) { const float w = a.subw[d0 * 32 + r32];
#pragma unroll
                for (int r = 0; r < 16; ++r) { const float v = o[d0][r] * ss[r] * w;
                    a.O[(a.qrow0 + qb * 32 + crow(r, hi)) * (long)a.opitch + a.ocol + d0 * 32 + r32] = (bf16_t)(cvtpk(v, v) & 0xffffu); } }
        }
    } else {
#pragma unroll
        for (int d0 = 0; d0 < 4; ++d0)
#pragma unroll
            for (int r = 0; r < 16; ++r) { const float v = o[d0][r] * fr[r];
                a.O[(a.qrow0 + qb * 32 + crow(r, hi)) * (long)a.opitch + a.ocol + var * 128 + d0 * 32 + r32] = (bf16_t)(cvtpk(v, v) & 0xffffu); }
    }
    __syncthreads();
}
#undef DI
}
namespace hg {
#define HG_LAS __attribute__((address_space(3)))
typedef unsigned short bf16_t;
typedef short bf16x8 __attribute__((ext_vector_type(8)));
typedef short s16x4 __attribute__((ext_vector_type(4)));
typedef float f32x16 __attribute__((ext_vector_type(16)));
typedef unsigned u32x4 __attribute__((ext_vector_type(4)));
typedef unsigned u32x2 __attribute__((ext_vector_type(2)));
typedef HG_LAS unsigned char lds_u8;
#define DI __device__ __forceinline__
using fa::crow; using fa::cvtpk; using fa::vtr; using fa::frag_rm; using fa::splat16;
constexpr int RP = 272;
constexpr int OFF_QP = 0, OFF_QPP = 17408, OFF_KPR = 34816, OFF_KPV = 52224, OFF_VV = 68608, OFF_SBT = 84992, OFF_SEG = 119808, OFF_EM = 123904, OFF_EL = 124416, HG_LDS = 124928;
constexpr float LOG2E = 1.4426950408889634f, LN2 = 0.6931471805599453f;
DI float bflo(unsigned w) { return __uint_as_float(w << 16); }
DI float bfhi(unsigned w) { return __uint_as_float(w & 0xffff0000u); }
DI int rm_off(int row, int k) { return row * RP + k * 2; }
DI int vs_off(int row, int col) { return (col >> 5) * 4096 + (row >> 4) * 1024 + (row & 15) * 64 + (col & 31) * 2; }

struct Args {
    const bf16_t* Bq; const bf16_t* Bf; const bf16_t* Bi; int pitch;
    bf16_t* O; int opitch; int ocol;
    const float* lb;
    int b, h, dir;
    int seg; float* P; float* Dl;
    int unit;
};

template <bool FULL>
DI void hgrn_unit(lds_u8* lds, const Args& a) {
    const int tid = threadIdx.x, lane = tid & 63, r32 = lane & 31, hi = lane >> 5;
    const int wid = __builtin_amdgcn_readfirstlane(tid >> 6);
    const int cp = lane, seg = wid;
    const int k0 = 2 * cp;
    const int ct = wid & 1, vb = wid >> 1;
    const int kt = wid & 3, vs0 = 2 * (wid >> 2);
    const int dir = a.dir;
    const float lb0 = a.lb[a.h * 128 + k0], lb1 = a.lb[a.h * 128 + k0 + 1];
    FA_LAS float* SEG = (FA_LAS float*)(lds + OFF_SEG);
    FA_LAS float* EM = (FA_LAS float*)(lds + OFF_EM);
    FA_LAS float* EL = (FA_LAS float*)(lds + OFF_EL);
    const long tokb = (long)a.b * 4096;
    const int colh = a.h * 128;
    f32x16 S[2]; S[0] = splat16(0.f); S[1] = splat16(0.f);
    if (FULL) {
        for (int i = 0; i < a.seg; ++i) {
            const int pu = a.unit - a.seg + i;
            const float* Pp = a.P + (((size_t)pu * 8 + wid) * 2) * 16 * 64 + lane; const float* Dp = a.Dl + (size_t)pu * 128 + 32 * kt;
#pragma unroll
            for (int r = 0; r < 16; ++r) { const float d = __builtin_amdgcn_exp2f(LOG2E * Dp[crow(r, hi)]);
                S[0][r] = d * S[0][r] + Pp[r * 64]; S[1][r] = d * S[1][r] + Pp[(16 + r) * 64]; }
        }
#pragma unroll
        for (int jj = 0; jj < 2; ++jj) { const int v = 32 * (vs0 + jj) + r32;
#pragma unroll
            for (int g = 0; g < 4; ++g) { const int k = 32 * kt + 8 * g + 4 * hi;
                *(FA_LAS u32x2*)(lds + OFF_SBT + rm_off(v, k)) = (u32x2){cvtpk(S[jj][4 * g], S[jj][4 * g + 1]), cvtpk(S[jj][4 * g + 2], S[jj][4 * g + 3])}; } }
    }
    float dsum0 = 0.f, dsum1 = 0.f;
    unsigned xr[8], qr[8]; u32x4 vr[2];
#define HG_GLOAD(n) do { const int m_ = dir ? 63 - (n) : (n); const long t0_ = tokb + (long)m_ * 64; \
      _Pragma("unroll") for (int i = 0; i < 8; ++i) { const int p = 8 * seg + i, orow = dir ? 63 - p : p; \
          xr[i] = *(const unsigned*)(a.Bf + (t0_ + orow) * a.pitch + colh + k0); if (FULL) qr[i] = *(const unsigned*)(a.Bq + (t0_ + orow) * a.pitch + colh + k0); } \
      _Pragma("unroll") for (int j = 0; j < 2; ++j) { const int pid = tid + 512 * j, piece = pid >> 6, l6 = pid & 63, row = 16 * (piece & 3) + (l6 >> 2), col = (piece >> 2) * 32 + (l6 & 3) * 8; \
          vr[j] = *(const u32x4*)(a.Bi + (t0_ + row) * a.pitch + colh + col); } } while (0)
    const int n_lo = 16 * a.seg, n_hi = n_lo + 16;
    HG_GLOAD(n_lo);
    for (int n = n_lo; n < n_hi; ++n) {
        const int m = dir ? 63 - n : n;
        float g0[8], g1[8], kk0[8], kk1[8], q0[8], q1[8];
        float c0 = 0.f, c1 = 0.f;
#pragma unroll
        for (int i = 0; i < 8; ++i) {
            const float x0 = bflo(xr[i]), x1 = bfhi(xr[i]);
            const float s0 = __builtin_amdgcn_rcpf(1.0f + __builtin_amdgcn_exp2f(-LOG2E * x0)), s1 = __builtin_amdgcn_rcpf(1.0f + __builtin_amdgcn_exp2f(-LOG2E * x1));
            const float f0 = lb0 + (1.0f - lb0) * s0, f1 = lb1 + (1.0f - lb1) * s1;
            c0 += __builtin_amdgcn_logf(f0) * LN2; c1 += __builtin_amdgcn_logf(f1) * LN2;
            g0[i] = c0; g1[i] = c1;
            kk0[i] = 1.0f - f0; kk1[i] = 1.0f - f1;
            if (FULL) { q0[i] = bflo(qr[i]); q1[i] = bfhi(qr[i]); } else { q0[i] = 0.f; q1[i] = 0.f; }
        }
        SEG[seg * 128 + k0] = c0; SEG[seg * 128 + k0 + 1] = c1;
#pragma unroll
        for (int j = 0; j < 2; ++j) *(FA_LAS u32x4*)(lds + OFF_VV + (tid + 512 * j) * 16) = vr[j];
        __syncthreads();
        if (n + 1 < n_hi) HG_GLOAD(n + 1);
        float pre0 = 0.f, pre1 = 0.f, bm0 = 0.f, bm1 = 0.f, bl0 = 0.f, bl1 = 0.f;
#pragma unroll
        for (int s = 0; s < 8; ++s) { const float t0 = SEG[s * 128 + k0], t1 = SEG[s * 128 + k0 + 1];
            if (s < seg) { pre0 += t0; pre1 += t1; } if (s < 4) { bm0 += t0; bm1 += t1; } bl0 += t0; bl1 += t1; }
        const float em0 = __builtin_amdgcn_exp2f(LOG2E * bm0), em1 = __builtin_amdgcn_exp2f(LOG2E * bm1);
        dsum0 += bl0; dsum1 += bl1;
        if (seg == 0) { EM[k0] = em0; EM[k0 + 1] = em1; EL[k0] = __builtin_amdgcn_exp2f(LOG2E * (bl0 - bm0)); EL[k0 + 1] = __builtin_amdgcn_exp2f(LOG2E * (bl1 - bm1)); }
#pragma unroll
        for (int i = 0; i < 8; ++i) {
            const int p = 8 * seg + i, orow = dir ? 63 - p : p;
            const float e0 = __builtin_amdgcn_exp2f(LOG2E * (pre0 + g0[i] - bm0)), e1 = __builtin_amdgcn_exp2f(LOG2E * (pre1 + g1[i] - bm1));
            const float qp0 = q0[i] * e0, qp1 = q1[i] * e1;
            const float kp0 = kk0[i] * __builtin_amdgcn_rcpf(e0), kp1 = kk1[i] * __builtin_amdgcn_rcpf(e1);
            const int ro = rm_off(orow, k0);
            const unsigned kpw = cvtpk(kp0, kp1);
            if (FULL) { *(FA_LAS unsigned*)(lds + OFF_QP + ro) = cvtpk(qp0, qp1);
                        *(FA_LAS unsigned*)(lds + OFF_QPP + ro) = cvtpk(qp0 * em0, qp1 * em1);
                        *(FA_LAS unsigned*)(lds + OFF_KPR + ro) = kpw; }
            *(FA_LAS unsigned*)(lds + OFF_KPV + vs_off(orow, k0)) = kpw;
        }
        __syncthreads();
        const int vlane = ((lane >> 4) & 1) * 32 + (lane & 3) * 8 + (4 * hi + ((lane & 15) >> 2)) * 64;
        if (FULL) {
        u32x4 pw[4];
        bool have[2];
#pragma unroll
        for (int st = 0; st < 2; ++st) {
            have[st] = dir ? (st >= ct) : (st <= ct);
            if (have[st]) {
                f32x16 acc = splat16(0.f);
#pragma unroll
                for (int ks = 0; ks < 8; ++ks) {
                    const bf16x8 af = frag_rm(lds + OFF_KPR, 32 * st + r32, 2 * ks + hi, RP), bfq = frag_rm(lds + OFF_QP, 32 * ct + r32, 2 * ks + hi, RP);
                    acc = __builtin_amdgcn_mfma_f32_32x32x16_bf16(af, bfq, acc, 0, 0, 0);
                }
                const int cc = 32 * ct + r32;
#pragma unroll
                for (int r = 0; r < 16; ++r) { const int s = 32 * st + crow(r, hi); const bool keep = dir ? (s >= cc) : (s <= cc); if (!keep) acc[r] = 0.f; }
#pragma unroll
                for (int j = 0; j < 4; ++j) { pw[2 * st][j] = cvtpk(acc[2 * j], acc[2 * j + 1]); pw[2 * st + 1][j] = cvtpk(acc[8 + 2 * j], acc[9 + 2 * j]); }
            }
        }
        f32x16 o = splat16(0.f);
#pragma unroll
        for (int ks = 0; ks < 4; ++ks) {
            if (have[ks >> 1]) {
                const lds_u8* vp = lds + OFF_VV + vb * 4096 + ks * 1024 + vlane;
                const s16x4 lo = vtr(vp), hh = vtr(vp + 512);
                const bf16x8 vf = (bf16x8){lo[0], lo[1], lo[2], lo[3], hh[0], hh[1], hh[2], hh[3]};
                o = __builtin_amdgcn_mfma_f32_32x32x16_bf16(__builtin_bit_cast(bf16x8, pw[ks]), vf, o, 0, 0, 0);
            }
        }
#pragma unroll
        for (int ks = 0; ks < 8; ++ks) {
            const bf16x8 af = frag_rm(lds + OFF_QPP, 32 * ct + r32, 2 * ks + hi, RP), bs = frag_rm(lds + OFF_SBT, 32 * vb + r32, 2 * ks + hi, RP);
            o = __builtin_amdgcn_mfma_f32_32x32x16_bf16(af, bs, o, 0, 0, 0);
        }
        { const long t0 = tokb + (long)m * 64;
#pragma unroll
          for (int r = 0; r < 16; ++r) a.O[(t0 + 32 * ct + crow(r, hi)) * a.opitch + a.ocol + colh + 32 * vb + r32] = (bf16_t)(cvtpk(o[r], o[r]) & 0xffffu); }
        }
        float emr[16], elr[16];
#pragma unroll
        for (int r = 0; r < 16; ++r) { emr[r] = EM[32 * kt + crow(r, hi)]; elr[r] = EL[32 * kt + crow(r, hi)]; }
#pragma unroll
        for (int jj = 0; jj < 2; ++jj) {
#pragma unroll
            for (int r = 0; r < 16; ++r) S[jj][r] *= emr[r];
#pragma unroll
            for (int ks = 0; ks < 4; ++ks) {
                const lds_u8* kp = lds + OFF_KPV + kt * 4096 + ks * 1024 + vlane;
                const lds_u8* vp = lds + OFF_VV + (vs0 + jj) * 4096 + ks * 1024 + vlane;
                const s16x4 klo = vtr(kp), khi = vtr(kp + 512), vlo = vtr(vp), vhi = vtr(vp + 512);
                const bf16x8 kf = (bf16x8){klo[0], klo[1], klo[2], klo[3], khi[0], khi[1], khi[2], khi[3]};
                const bf16x8 vf = (bf16x8){vlo[0], vlo[1], vlo[2], vlo[3], vhi[0], vhi[1], vhi[2], vhi[3]};
                S[jj] = __builtin_amdgcn_mfma_f32_32x32x16_bf16(kf, vf, S[jj], 0, 0, 0);
            }
#pragma unroll
            for (int r = 0; r < 16; ++r) S[jj][r] *= elr[r];
        }
        __syncthreads();
        if (FULL)
#pragma unroll
        for (int jj = 0; jj < 2; ++jj) { const int v = 32 * (vs0 + jj) + r32;
#pragma unroll
            for (int g = 0; g < 4; ++g) { const int k = 32 * kt + 8 * g + 4 * hi;
                *(FA_LAS u32x2*)(lds + OFF_SBT + rm_off(v, k)) = (u32x2){cvtpk(S[jj][4 * g], S[jj][4 * g + 1]), cvtpk(S[jj][4 * g + 2], S[jj][4 * g + 3])}; } }
    }
#undef HG_GLOAD
    if (!FULL) {
        float* Pp = a.P + (((size_t)a.unit * 8 + wid) * 2) * 16 * 64 + lane;
#pragma unroll
        for (int r = 0; r < 16; ++r) { Pp[r * 64] = S[0][r]; Pp[(16 + r) * 64] = S[1][r]; }
        if (seg == 0) { a.Dl[(size_t)a.unit * 128 + k0] = dsum0; a.Dl[(size_t)a.unit * 128 + k0 + 1] = dsum1; }
    }
    __syncthreads();
}
#undef DI
}
namespace nv {
#define NV_LAS __attribute__((address_space(3)))
typedef unsigned short bf16_t;
__device__ __forceinline__ float bf2f(bf16_t v) { return __uint_as_float(((unsigned)v) << 16); }
__device__ __forceinline__ bf16_t f2bf_(float f) { unsigned u = __builtin_bit_cast(unsigned, f); return (bf16_t)((u + 0x7fffu + ((u >> 16) & 1u)) >> 16); }
__device__ __forceinline__ void hgrn_naive(NV_LAS unsigned char* lds, const hg::Args& a) {
    const int tid = threadIdx.x, v = tid & 127, kg = tid >> 7;
    NV_LAS float* F = (NV_LAS float*)lds; NV_LAS float* KK = F + 128; NV_LAS float* Q = KK + 128; NV_LAS float* PO = Q + 128;
    float S[32];
#pragma unroll
    for (int i = 0; i < 32; ++i) S[i] = 0.f;
    const float lb = a.lb[a.h * 128 + (tid & 127)];
    for (int p = 0; p < 4096; ++p) {
        const int t = a.dir ? 4095 - p : p;
        const long row = (long)a.b * 4096 + t;
        if (tid < 128) {
            const float x = bf2f(a.Bf[row * a.pitch + a.h * 128 + tid]);
            const float sg = 1.0f / (1.0f + expf(-x));
            const float f = lb + (1.0f - lb) * sg;
            F[tid] = f; KK[tid] = 1.0f - f; Q[tid] = bf2f(a.Bq[row * a.pitch + a.h * 128 + tid]);
        }
        const float vv = bf2f(a.Bi[row * a.pitch + a.h * 128 + v]);
        __syncthreads();
        float po = 0.f;
#pragma unroll
        for (int i = 0; i < 32; ++i) { const int k = kg * 32 + i; S[i] = F[k] * S[i] + KK[k] * vv; po += Q[k] * S[i]; }
        PO[kg * 128 + v] = po;
        __syncthreads();
        if (kg == 0) a.O[row * a.opitch + a.ocol + a.h * 128 + v] = f2bf_(PO[v] + PO[128 + v] + PO[256 + v] + PO[384 + v]);
    }
    __syncthreads();
}
__device__ __forceinline__ void cross_naive_row(NV_LAS float* pl  , const bf16_t* Q, const bf16_t* MK, const bf16_t* MV, bf16_t* O, int lane) {
    float s[4];
#pragma unroll
    for (int j = 0; j < 4; ++j) { const int key = lane * 4 + j; float acc = 0.f; for (int d = 0; d < 256; ++d) acc += bf2f(Q[d]) * bf2f(MK[(long)key * 1024 + d]); s[j] = acc; }
    float m = fmaxf(fmaxf(s[0], s[1]), fmaxf(s[2], s[3]));
#pragma unroll
    for (int o = 1; o < 64; o <<= 1) m = fmaxf(m, __shfl_xor(m, o));
    float l = 0.f;
#pragma unroll
    for (int j = 0; j < 4; ++j) { s[j] = exp2f(s[j] - m); l += s[j]; }
#pragma unroll
    for (int o = 1; o < 64; o <<= 1) l += __shfl_xor(l, o);
#pragma unroll
    for (int j = 0; j < 4; ++j) pl[lane * 4 + j] = s[j] / l;
    float acc[4] = {0.f, 0.f, 0.f, 0.f};
    for (int key = 0; key < 256; ++key) { const float pk = pl[key];
#pragma unroll
        for (int j = 0; j < 4; ++j) acc[j] += pk * bf2f(MV[(long)key * 1024 + lane * 4 + j]); }
#pragma unroll
    for (int j = 0; j < 4; ++j) O[lane * 4 + j] = f2bf_(acc[j]);
}
__device__ __forceinline__ void diff_naive_row(NV_LAS float* wl  , const bf16_t* q0p, const bf16_t* q1p, const bf16_t* K, int kc0, int kc1, const bf16_t* V, int vc,
                                               int qpos, const float* relb, int head, float lam, const float* subw, bf16_t* O, int lane) {
    NV_LAS float* qs = wl + 4096;
    qs[lane] = bf2f(q0p[lane]); qs[64 + lane] = bf2f(q1p[lane]);
    float m0 = -1e30f, m1 = -1e30f, l0 = 0.f, l1 = 0.f;
    for (int i = 0; i < 64; ++i) { const int key = lane + 64 * i; const bf16_t* k0 = K + (long)key * 1024 + kc0; const bf16_t* k1 = K + (long)key * 1024 + kc1;
        float s0 = 0.f, s1 = 0.f; for (int d = 0; d < 64; ++d) { s0 += qs[d] * bf2f(k0[d]); s1 += qs[64 + d] * bf2f(k1[d]); }
        const float bias = relb[fa::t5_bucket(key - qpos) * 8 + head] * 1.4426950408889634f; s0 += bias; s1 += bias;
        if (s0 > m0) { l0 *= exp2f(m0 - s0); m0 = s0; } l0 += exp2f(s0 - m0);
        if (s1 > m1) { l1 *= exp2f(m1 - s1); m1 = s1; } l1 += exp2f(s1 - m1); }
    float M0 = m0, M1 = m1;
#pragma unroll
    for (int o = 1; o < 64; o <<= 1) { M0 = fmaxf(M0, __shfl_xor(M0, o)); M1 = fmaxf(M1, __shfl_xor(M1, o)); }
    l0 *= exp2f(m0 - M0); l1 *= exp2f(m1 - M1);
#pragma unroll
    for (int o = 1; o < 64; o <<= 1) { l0 += __shfl_xor(l0, o); l1 += __shfl_xor(l1, o); }
    for (int i = 0; i < 64; ++i) { const int key = lane + 64 * i; const bf16_t* k0 = K + (long)key * 1024 + kc0; const bf16_t* k1 = K + (long)key * 1024 + kc1;
        float s0 = 0.f, s1 = 0.f; for (int d = 0; d < 64; ++d) { s0 += qs[d] * bf2f(k0[d]); s1 += qs[64 + d] * bf2f(k1[d]); }
        const float bias = relb[fa::t5_bucket(key - qpos) * 8 + head] * 1.4426950408889634f; s0 += bias; s1 += bias;
        wl[key] = exp2f(s0 - M0) / l0 - lam * exp2f(s1 - M1) / l1; }
    float a0 = 0.f, a1 = 0.f;
    for (int key = 0; key < 4096; ++key) { const float w = wl[key]; const unsigned vv = *(const unsigned*)(V + (long)key * 1024 + vc + 2 * lane);
        a0 += w * __uint_as_float(vv << 16); a1 += w * __uint_as_float(vv & 0xffff0000u); }
    float ss = a0 * a0 + a1 * a1;
#pragma unroll
    for (int o = 1; o < 64; o <<= 1) ss += __shfl_xor(ss, o);
    const float rstd = 0.8f / sqrtf(ss * (1.f / 128.f) + 1e-6f);
    O[2 * lane] = f2bf_(a0 * rstd * subw[2 * lane]); O[2 * lane + 1] = f2bf_(a1 * rstd * subw[2 * lane + 1]);
}
}
constexpr int D = 1024, BATCH = 4, SEQ = 4096, M_TOK = BATCH * SEQ, NMEM = 256, INC = 14336;
constexpr size_t MiB = 1u << 20;
constexpr size_t WS_TAB = 0;
constexpr size_t WS_BAR = 65536;
constexpr size_t WS_WIN = 1 * MiB;
constexpr size_t WS_WBR = 29 * MiB;
constexpr size_t WS_WOUT = 35 * MiB;
constexpr size_t WS_WMEM = 37 * MiB;
constexpr size_t WS_MK = 41 * MiB, WS_MV = 43 * MiB;
constexpr size_t WS_MN = 45 * MiB;
constexpr size_t WS_H = 47 * MiB;
constexpr size_t WS_OG = 79 * MiB;
constexpr size_t WS_T1 = 175 * MiB;
constexpr size_t WS_HP = 239 * MiB;
constexpr size_t WS_HD = 255 * MiB;
constexpr size_t WS_END = 255 * MiB + 131072;
static_assert(WS_END <= 256 * MiB, "ws map");
constexpr int LDS_BYTES = 147456;
#ifdef NAIVE_HGRN
#define HGRN_CALL nv::hgrn_naive
#else
#define HGRN_CALL hg::hgrn_unit<true>
#endif

typedef unsigned short bf16;
typedef float f32x4v __attribute__((ext_vector_type(4)));
typedef unsigned v4u __attribute__((ext_vector_type(4)));

struct Params {
    const float *x, *mem, *pre_norm, *post_norm, *w_in, *lq1, *lk1, *lq2, *lk2, *subln, *relb, *lbl, *hnorm, *mnorm, *w_memkv, *w_branch, *w_out;
    float* out; unsigned char* ws; int ph_lo, ph_hi;
};

__device__ __forceinline__ unsigned f2bf(float f) { unsigned u = __builtin_bit_cast(unsigned, f); return (u + 0x7fffu + ((u >> 16) & 1u)) >> 16; }
__device__ __forceinline__ unsigned pk2(float lo, float hi) { return f2bf(lo) | (f2bf(hi) << 16); }
__device__ __forceinline__ float wave_sum(float v) {
#pragma unroll
    for (int o = 1; o < 64; o <<= 1) v += __shfl_xor(v, o);
    return v;
}
__device__ __forceinline__ int win_dst_row(int n0) {
    const int seg = n0 >> 10, w = n0 & 1023;
    const int perm = ((w >> 6) & 7) * 128 + (w >> 9) * 64 + (w & 63);
    switch (seg) {
        case 0: return 5120 + perm; case 1: return 6144 + perm; case 2: return 7168 + w; case 3: return 8192 + w;
        case 4: return 0 + w; case 5: return 1024 + w; case 6: return 2048 + w; case 7: return 3072 + w; case 8: return 9216 + w;
        case 9: return 4096 + w; case 10: return 10240 + w; case 11: return 11264 + w; case 12: return 12288 + w; default: return 13312 + w;
    }
}
__device__ __forceinline__ void p0_transpose_item(const float* W, int K, int N, bf16* WT, int dst_row0, int kb, int n0, LAS float* scr, int lane) {
    const int k0 = 64 * kb;
#pragma unroll 8
    for (int i = 0; i < 32; ++i) { const int kk = 2 * i + (lane >> 5); scr[kk * 33 + (lane & 31)] = W[(size_t)(k0 + kk) * N + n0 + (lane & 31)]; }
    asm volatile("s_waitcnt lgkmcnt(0)" ::: "memory");
    const int c = lane & 7;
#pragma unroll
    for (int j = 0; j < 4; ++j) { const int n = (lane >> 3) + 8 * j; const LAS float* s = scr + (8 * c) * 33 + n;
        v4u o; o.x = pk2(s[0 * 33], s[1 * 33]); o.y = pk2(s[2 * 33], s[3 * 33]); o.z = pk2(s[4 * 33], s[5 * 33]); o.w = pk2(s[6 * 33], s[7 * 33]);
        *(v4u*)(WT + (size_t)(dst_row0 + n) * K + k0 + 8 * c) = o; }
    asm volatile("s_waitcnt lgkmcnt(0)" ::: "memory");
}
__device__ __forceinline__ void rms_row_to_bf16(const float* xrow, const float* w, bf16* orow, int lane) {
    const f32x4v* xr = (const f32x4v*)xrow + lane; const f32x4v* wr = (const f32x4v*)w + lane;
    f32x4v v[4]; float s = 0.f;
#pragma unroll
    for (int j = 0; j < 4; ++j) { v[j] = xr[64 * j]; s += (v[j].x * v[j].x + v[j].y * v[j].y) + (v[j].z * v[j].z + v[j].w * v[j].w); }
    const float rstd = 1.0f / sqrtf(wave_sum(s) * (1.f / 1024.f) + 1e-6f);
    unsigned long long* o8 = (unsigned long long*)orow + lane;
#pragma unroll
    for (int j = 0; j < 4; ++j) { const f32x4v ww = wr[64 * j];
        o8[64 * j] = (unsigned long long)pk2(v[j].x * rstd * ww.x, v[j].y * rstd * ww.y) | ((unsigned long long)pk2(v[j].z * rstd * ww.z, v[j].w * rstd * ww.w) << 32); }
}

__global__ void __launch_bounds__(512, 2) fwd_kernel(Params p) {
    extern __shared__ __attribute__((aligned(16))) unsigned char lds_raw[];
    LAS unsigned char* lds = (LAS unsigned char*)lds_raw;
    const int tid = threadIdx.x, lane = tid & 63, wave = __builtin_amdgcn_readfirstlane(tid >> 6);
    const int G = gridDim.x, bx = blockIdx.x;
    const int vcu = (G % 8 == 0) ? (bx % 8) * (G / 8) + bx / 8 : bx;
    unsigned char* ws = p.ws;
    float* TAB = (float*)(ws + WS_TAB);
    bf16* WinT = (bf16*)(ws + WS_WIN); bf16* WbrT = (bf16*)(ws + WS_WBR); bf16* WoutT = (bf16*)(ws + WS_WOUT); bf16* WmemT = (bf16*)(ws + WS_WMEM);
    bf16* MK = (bf16*)(ws + WS_MK); bf16* MV = (bf16*)(ws + WS_MV); bf16* MN = (bf16*)(ws + WS_MN);
    bf16* H = (bf16*)(ws + WS_H); bf16* MG = H; bf16* OG = (bf16*)(ws + WS_OG);
    bf16* T1a = (bf16*)(ws + WS_T1); bf16* T1b = (bf16*)(ws + WS_T1 + 32 * MiB);
    bf16* DOa = (bf16*)p.out; bf16* DOb = (bf16*)((unsigned char*)p.out + 32 * MiB);
    const int lo = p.ph_lo, hi = p.ph_hi;
    volatile LAS unsigned* MISC = (volatile LAS unsigned*)(lds + LDS_BYTES - 256);
    if (tid < 2) MISC[tid] = 0u;
    __syncthreads();
    XcdBarrier bar = xcd_barrier_post((unsigned*)(ws + WS_BAR), MISC);
#ifndef PHASE_MASK
#define PHASE_MASK 0x7ff
#endif
#define IN(k) (((PHASE_MASK >> (k)) & 1) && lo <= (k) && (k) < hi)
#define SEAM(k) do { if (IN(k) && IN((k) + 1)) xcd_barrier(bar); } while (0)

    if (IN(0)) {
        LAS float* scr = (LAS float*)(lds + wave * 16384);
        const int gw = vcu * 8 + wave, NGW = G * 8;
        constexpr int I_IN = 16 * (INC / 32), I_BR = 3 * 16 * 32, I_OUT = 16 * 32, I_MEM = 16 * 64, NITEMS = I_IN + I_BR + I_OUT + I_MEM;
        for (int it = gw; it < NITEMS; it += NGW) {
            int r = it;
            if (r < I_IN) { const int nb = r % (INC / 32), kb = r / (INC / 32); p0_transpose_item(p.w_in, D, INC, WinT, win_dst_row(nb * 32), kb, nb * 32, scr, lane); continue; } r -= I_IN;
            if (r < I_BR) { const int b = r / 512, q = r % 512, nb = q % 32, kb = q / 32; p0_transpose_item(p.w_branch + (size_t)b * D * D, D, D, WbrT + (size_t)b * D * D, nb * 32, kb, nb * 32, scr, lane); continue; } r -= I_BR;
            if (r < I_OUT) { const int nb = r % 32, kb = r / 32; p0_transpose_item(p.w_out, D, D, WoutT, nb * 32, kb, nb * 32, scr, lane); continue; } r -= I_OUT;
            { const int nb = r % 64, kb = r / 64; p0_transpose_item(p.w_memkv, D, 2 * D, WmemT, nb * 32, kb, nb * 32, scr, lane); }
        }
        for (int m = gw; m < M_TOK; m += NGW) rms_row_to_bf16(p.x + (size_t)m * D, p.pre_norm, H + (size_t)m * D, lane);
        for (int m = gw; m < BATCH * NMEM; m += NGW) rms_row_to_bf16(p.mem + (size_t)m * D, p.mnorm, MN + (size_t)m * D, lane);
        if (bx == 0) {
            if (wave == 0) { float a = p.lq1[lane] * p.lk1[lane], b = p.lq2[lane] * p.lk2[lane]; a = wave_sum(a); b = wave_sum(b); if (lane == 0) TAB[0] = expf(a) - expf(b) + 0.2f; }
            for (int i = tid; i < 2048; i += 512) { const int dir = i >> 10, kc = i & 1023; const float a0 = p.lbl[dir * 2048 + kc], a1 = p.lbl[dir * 2048 + 1024 + kc];
                TAB[16 + i] = 1.0f / (1.0f + expf(a1 - a0)); }
        }
    }
    SEAM(0);
    if (IN(1)) {
        { pg8::Gemm g{H, WinT, M_TOK, 5120, D, D, D}; pg8::StaticOrder S; S.init(M_TOK, 5120, G, bx);
          pg8::EpiRoute<0> E{T1a, DOa, DOb, T1b, OG, 1024, 1024, 1024, 1024, 3072, 0, 0, 0, 0, 2048, 1.f, 1.f, 1.f, 1.f, 0.0625f * 1.4426950408889634f};
          pg8::gemm_phase<pg8::EpiRoute<0>, pg8::StaticOrder, true>(lds, g, S, E); }
    }
    SEAM(1);
#ifdef CHECK1
    {
        unsigned* ctl = (unsigned*)(ws + WS_TAB) + 8192;
        xcd_barrier(bar);
        const size_t gt = (size_t)bx * 512 + tid, gs = (size_t)G * 512;
        for (size_t i = gt; i < (size_t)D * INC; i += gs) { const int k = (int)(i / INC), n = (int)(i % INC);
            const unsigned e = f2bf(p.w_in[i]); const unsigned a = WinT[(size_t)(win_dst_row(n & ~31) + (n & 31)) * D + k];
            if (e != a) atomicMax(ctl, 100u + (unsigned)(n >> 10)); }
        { const int gw = vcu * 8 + wave, NGW = G * 8;
          for (int m = gw; m < M_TOK; m += NGW) { const float* xr = p.x + (size_t)m * D; float s = 0.f; for (int j = lane; j < D; j += 64) s += xr[j] * xr[j];
              s = wave_sum(s); const float rstd = 1.0f / sqrtf(s * (1.f / 1024.f) + 1e-6f);
              for (int j = lane; j < D; j += 64) { const float e = xr[j] * rstd * p.pre_norm[j]; const float a = __uint_as_float(((unsigned)H[(size_t)m * D + j]) << 16);
                  if (fabsf(e - a) > 0.01f * fabsf(e) + 1e-3f) atomicMax(ctl, 200u); } } }
        for (size_t i = gt; i < (size_t)64 * 5120; i += gs) { const int sr = (int)(i / 5120), c = (int)(i % 5120); const int row = (sr < 4) ? (sr == 0 ? 0 : sr == 1 ? 255 : sr == 2 ? 256 : 16383) : (sr * 263 + 7) % M_TOK;
            float acc = 0.f; for (int k = 0; k < D; ++k) acc += __uint_as_float(((unsigned)H[(size_t)row * D + k]) << 16) * __uint_as_float(((unsigned)WinT[(size_t)c * D + k]) << 16);
            const int g = c >> 10, cw = c & 1023; float got;
            if (g == 0) got = __uint_as_float(((unsigned)T1a[(size_t)row * 1024 + cw]) << 16); else if (g == 1) got = __uint_as_float(((unsigned)DOa[(size_t)row * 1024 + cw]) << 16);
            else if (g == 2) got = __uint_as_float(((unsigned)DOb[(size_t)row * 1024 + cw]) << 16); else if (g == 3) got = __uint_as_float(((unsigned)T1b[(size_t)row * 1024 + cw]) << 16);
            else { got = __uint_as_float(((unsigned)OG[(size_t)row * 3072 + 2048 + cw]) << 16); acc *= 0.0625f * 1.4426950408889634f; }
            if (!(fabsf(acc - got) <= 0.02f * fabsf(acc) + 0.02f)) atomicMax(ctl, 300u + (unsigned)g); }
        xcd_barrier(bar);
        const float code = (float)__hip_atomic_load(ctl, __ATOMIC_RELAXED, __HIP_MEMORY_SCOPE_AGENT);
        for (size_t i = gt; i < (size_t)M_TOK * D; i += gs) p.out[i] = (i == 0) ? (code == 0.f ? 777.f : code) : 0.f;
        return;
    }
#endif
    float* HP = (float*)(ws + WS_HP); float* HD = (float*)(ws + WS_HD);
    if (IN(2)) {
        for (int u = vcu; u < 256; u += G) { const int seg = u & 3, dir = (u >> 2) & 1, bh = u >> 3;
            if (seg < 3) { hg::Args a{T1a, dir ? DOb : DOa, T1b, 1024, OG, 3072, dir ? 0 : 1024, TAB + 16 + dir * 1024, bh >> 3, bh & 7, dir, seg, HP, HD, u}; hg::hgrn_unit<false>(lds, a); }
            else if (G == 256) {
                pg8::Gemm g{MN, WmemT, BATCH * NMEM, 2048, D, D, D}; pg8::StaticOrder S; S.init(BATCH * NMEM, 2048, 64, u >> 2);
                pg8::EpiRoute<0> E{MK, MV, MV, MV, MV, 1024, 1024, 1024, 1024, 1024, 0, 0, 0, 0, 0, 1.f, 1.f, 1.f, 1.f, 1.f};
                pg8::gemm_phase<pg8::EpiRoute<0>, pg8::StaticOrder, true>(lds, g, S, E); } }
        if (G != 256) { pg8::Gemm g{MN, WmemT, BATCH * NMEM, 2048, D, D, D}; pg8::StaticOrder S; S.init(BATCH * NMEM, 2048, G, bx);
            pg8::EpiRoute<0> E{MK, MV, MV, MV, MV, 1024, 1024, 1024, 1024, 1024, 0, 0, 0, 0, 0, 1.f, 1.f, 1.f, 1.f, 1.f};
            pg8::gemm_phase<pg8::EpiRoute<0>, pg8::StaticOrder, true>(lds, g, S, E); }
    }
    SEAM(2);
    if (IN(3)) {
        for (int u = vcu; u < 256; u += G) { const int seg = u & 3, dir = (u >> 2) & 1, bh = u >> 3;
            hg::Args a{T1a, dir ? DOb : DOa, T1b, 1024, OG, 3072, dir ? 0 : 1024, TAB + 16 + dir * 1024, bh >> 3, bh & 7, dir, seg, HP, HD, u}; hg::hgrn_unit<true>(lds, a); }
        for (int u = vcu; u < 512; u += G) {
            const int b = u >> 7, head = (u >> 5) & 3, qblk = u & 31;
            fa::UnitArgs a{OG, 3072, 2048 + head * 256, 2048 + head * 256, (long)b * SEQ + qblk * 128, MK, 1024, head * 256, head * 256, MV, 1024, head * 256,
                           (long)b * NMEM, NMEM, OG, 3072, 2048 + head * 256, 0, nullptr, 0, 0.f, nullptr};
            fa::attn_unit<256, false>(lds, a);
        }
    }
    SEAM(3);
    if (IN(4)) {
        const int gw = vcu * 8 + wave, NGW = G * 8;
        for (int m = gw; m < M_TOK; m += NGW) {
            bf16* rowp = OG + (size_t)m * 3072;
            const v4u f0 = *(const v4u*)(rowp + 1024 + lane * 16), f1 = *(const v4u*)(rowp + 1024 + lane * 16 + 8);
            const v4u b0 = *(const v4u*)(rowp + lane * 16), b1 = *(const v4u*)(rowp + lane * 16 + 8);
            float v[16];
            const unsigned fw[8] = {f0.x, f0.y, f0.z, f0.w, f1.x, f1.y, f1.z, f1.w}, bw[8] = {b0.x, b0.y, b0.z, b0.w, b1.x, b1.y, b1.z, b1.w};
            float s = 0.f;
#pragma unroll
            for (int j = 0; j < 8; ++j) { v[2 * j] = __uint_as_float(fw[j] << 16) + __uint_as_float(bw[j] << 16); v[2 * j + 1] = __uint_as_float(fw[j] & 0xffff0000u) + __uint_as_float(bw[j] & 0xffff0000u);
                s += v[2 * j] * v[2 * j] + v[2 * j + 1] * v[2 * j + 1]; }
            s += __shfl_xor(s, 1); s += __shfl_xor(s, 2); s += __shfl_xor(s, 4);
            const float rstd = 1.0f / sqrtf(s * (1.f / 128.f) + 1e-6f);
            const float* hw = p.hnorm + (lane & 7) * 16;
            v4u o0, o1;
            o0.x = pk2(v[0] * rstd * hw[0], v[1] * rstd * hw[1]); o0.y = pk2(v[2] * rstd * hw[2], v[3] * rstd * hw[3]); o0.z = pk2(v[4] * rstd * hw[4], v[5] * rstd * hw[5]); o0.w = pk2(v[6] * rstd * hw[6], v[7] * rstd * hw[7]);
            o1.x = pk2(v[8] * rstd * hw[8], v[9] * rstd * hw[9]); o1.y = pk2(v[10] * rstd * hw[10], v[11] * rstd * hw[11]); o1.z = pk2(v[12] * rstd * hw[12], v[13] * rstd * hw[13]); o1.w = pk2(v[14] * rstd * hw[14], v[15] * rstd * hw[15]);
            *(v4u*)(rowp + 1024 + lane * 16) = o0; *(v4u*)(rowp + 1024 + lane * 16 + 8) = o1;
        }
    }
    SEAM(4);
    if (IN(5)) {
        pg8::Gemm g{H, WinT + (size_t)5120 * D, M_TOK, 3072, D, D, D}; pg8::StaticOrder S; S.init(M_TOK, 3072, G, bx);
        pg8::EpiRoute<0> E{OG, DOa, DOb, DOb, DOb, 3072, 1024, 1024, 1024, 1024, 0, 0, 0, 0, 0, 0.125f * 1.4426950408889634f, 1.f, 1.f, 1.f, 1.f};
        pg8::gemm_phase<pg8::EpiRoute<0>, pg8::StaticOrder, true>(lds, g, S, E);
    }
    SEAM(5);
    if (IN(6)) {
        const float lam = TAB[0];
#ifdef NAIVE_DIFF
        for (int it = vcu * 8 + wave; it < M_TOK * 8; it += G * 8) { const int h = it & 7, row = it >> 3, b = row >> 12, qpos = row & 4095;
            bf16* qo = OG + (size_t)row * 3072 + h * 128;
            nv::diff_naive_row((LAS float*)lds + wave * 4224, qo, qo + 64, DOa + (size_t)b * SEQ * 1024, h * 128, h * 128 + 64, DOb + (size_t)b * SEQ * 1024, h * 128, qpos, p.relb, h, lam, p.subln, qo, lane); }
#endif
        for (int u = vcu; u < 1024; u += G) {
#ifdef NAIVE_DIFF
            break;
#endif
            const int bh = u >> 5, qblk = u & 31, b = bh >> 3, h = bh & 7;
            fa::UnitArgs a{OG, 3072, h * 128, h * 128 + 64, (long)b * SEQ + qblk * 128, DOa, 1024, h * 128, h * 128 + 64, DOb, 1024, h * 128,
                           (long)b * SEQ, SEQ, OG, 3072, h * 128, qblk * 128, p.relb, h, lam, p.subln};
            fa::attn_unit<64, true>(lds, a);
        }
#if defined(PROBE_DUP) && PROBE_DUP == 5
        for (int u = vcu; u < 1024; u += G) {
            const int bh = u >> 5, qblk = u & 31, b = bh >> 3, h = bh & 7;
            fa::UnitArgs a{OG, 3072, h * 128, h * 128 + 64, (long)b * SEQ + qblk * 128, DOa, 1024, h * 128, h * 128 + 64, DOb, 1024, h * 128,
                           (long)b * SEQ, SEQ, T1a, 1024, h * 128, qblk * 128, p.relb, h, lam, p.subln};
            fa::attn_unit<64, true>(lds, a);
        }
#endif
    }
    SEAM(6);
#ifdef CHECK2
#define SROW(sr) (((sr) < 4) ? ((sr) == 0 ? 0 : (sr) == 1 ? 255 : (sr) == 2 ? 256 : 16383) : ((sr) * 263 + 7) % M_TOK)
#define BF(v) __uint_as_float(((unsigned)(v)) << 16)
    unsigned* ctl = (unsigned*)(ws + WS_TAB) + 8192;
    bf16* SAVE = (bf16*)(ws + 240 * MiB);
    const size_t gt = (size_t)bx * 512 + tid, gs = (size_t)G * 512;
    for (size_t i = gt; i < (size_t)64 * 3072; i += gs) SAVE[i] = OG[(size_t)SROW((int)(i / 3072)) * 3072 + (i % 3072)];
    xcd_barrier(bar);
#endif
    if (IN(7)) {
        { pg8::Gemm g{H, WinT + (size_t)8192 * D, M_TOK, 3072, D, D, D}; pg8::StaticOrder S; S.init(M_TOK, 3072, G, bx);
          pg8::EpiRoute<1> E{OG, OG, OG, OG, OG, 3072, 3072, 3072, 3072, 3072, 0, 1024, 2048, 0, 0, 1.f, 1.f, 1.f, 1.f, 1.f};
          pg8::gemm_phase<pg8::EpiRoute<1>, pg8::StaticOrder, true>(lds, g, S, E); }
        { pg8::Gemm g{H, WinT + (size_t)11264 * D, M_TOK, 3072, D, D, D}; pg8::StaticOrder S; S.init(M_TOK, 3072, G, bx);
          pg8::EpiRoute<2> E{DOa, DOb, T1a, T1a, T1a, 1024, 1024, 1024, 1024, 1024, 0, 0, 0, 0, 0, 1.f, 1.f, 1.f, 1.f, 1.f};
          pg8::gemm_phase<pg8::EpiRoute<2>, pg8::StaticOrder, true>(lds, g, S, E); }
    }
    SEAM(7);
#ifdef CHECK2
    xcd_barrier(bar);
    for (size_t i = gt; i < (size_t)64 * 3072; i += gs) { const int sr = (int)(i / 3072), c = (int)(i % 3072), row = SROW(sr);
        float z = 0.f, gg = 0.f; for (int k = 0; k < D; ++k) { const float hv = BF(H[(size_t)row * D + k]); z += hv * BF(WinT[(size_t)(8192 + c) * D + k]); gg += hv * BF(WinT[(size_t)(11264 + c) * D + k]); }
        const float e1 = z / (1.0f + expf(-z)) * BF(SAVE[i]); const float a1 = BF(OG[(size_t)row * 3072 + c]);
        if (!(fabsf(e1 - a1) <= 0.03f * fabsf(e1) + 0.02f)) atomicMax(ctl, 600u + (unsigned)(c >> 10));
        const float e2 = 1.0f / (1.0f + expf(-gg)); const bf16* gb_ = (c < 1024) ? DOa : (c < 2048 ? DOb : T1a); const float a2 = BF(gb_[(size_t)row * 1024 + (c & 1023)]);
        if (!(fabsf(e2 - a2) <= 0.02f)) atomicMax(ctl, 650u + (unsigned)(c >> 10)); }
    xcd_barrier(bar);
#endif
    if (IN(8)) {
        pg8::StaticOrder S; S.init(M_TOK, D, G, bx);
        { pg8::Gemm g{OG, WbrT, M_TOK, D, D, 3072, D}; pg8::EpiBranch<true> E{DOa, MG, 1024, 1024}; pg8::gemm_phase<pg8::EpiBranch<true>, pg8::StaticOrder, false>(lds, g, S, E); }
        { pg8::Gemm g{OG + 1024, WbrT + (size_t)D * D, M_TOK, D, D, 3072, D}; pg8::EpiBranch<false> E{DOb, MG, 1024, 1024}; pg8::gemm_phase<pg8::EpiBranch<false>, pg8::StaticOrder, false>(lds, g, S, E); }
        { pg8::Gemm g{OG + 2048, WbrT + (size_t)2 * D * D, M_TOK, D, D, 3072, D}; pg8::EpiBranch<false> E{T1a, MG, 1024, 1024}; pg8::gemm_phase<pg8::EpiBranch<false>, pg8::StaticOrder, false>(lds, g, S, E); }
    }
    SEAM(8);
#ifdef CHECK2
    xcd_barrier(bar);
    for (size_t i = gt; i < (size_t)64 * 1024; i += gs) { const int sr = (int)(i / 1024), n = (int)(i % 1024), row = SROW(sr);
        float e = 0.f;
        for (int b = 0; b < 3; ++b) { float acc = 0.f; for (int k = 0; k < D; ++k) acc += BF(OG[(size_t)row * 3072 + b * 1024 + k]) * BF(WbrT[((size_t)b * D + n) * D + k]);
            const bf16* gb_ = (b == 0) ? DOa : (b == 1 ? DOb : T1a); e += acc * BF(gb_[(size_t)row * 1024 + n]); }
        const float a = BF(MG[(size_t)row * 1024 + n]);
        if (!(fabsf(e - a) <= 0.03f * fabsf(e) + 0.03f)) atomicMax(ctl, 500u); }
    xcd_barrier(bar);
#endif
    if (IN(9)) {
        pg8::Gemm g{MG, WoutT, M_TOK, D, D, D, D}; pg8::StaticOrder S; S.init(M_TOK, D, G, bx);
        pg8::EpiF32 E{p.out, D};
        pg8::gemm_phase<pg8::EpiF32, pg8::StaticOrder, false>(lds, g, S, E);
    }
    SEAM(9);
    if (IN(10)) {
        const int gw = vcu * 8 + wave, NGW = G * 8;
        for (int m = gw; m < M_TOK; m += NGW) {
            f32x4v* yr = (f32x4v*)(p.out + (size_t)m * D) + lane; const f32x4v* xr = (const f32x4v*)(p.x + (size_t)m * D) + lane; const f32x4v* wr = (const f32x4v*)p.post_norm + lane;
            f32x4v v[4]; float s = 0.f;
#pragma unroll
            for (int j = 0; j < 4; ++j) { v[j] = yr[64 * j]; s += (v[j].x * v[j].x + v[j].y * v[j].y) + (v[j].z * v[j].z + v[j].w * v[j].w); }
            const float rstd = 1.0f / sqrtf(wave_sum(s) * (1.f / 1024.f) + 1e-6f);
#pragma unroll
            for (int j = 0; j < 4; ++j) yr[64 * j] = xr[64 * j] + v[j] * rstd * wr[64 * j];
        }
    }
#ifdef CHECK2
    xcd_barrier(bar);
    { const int gw = vcu * 8 + wave, NGW = G * 8; LAS float* yb = (LAS float*)lds + wave * 1024;
      for (int sr = gw; sr < 64; sr += NGW) { const int row = SROW(sr); float ss = 0.f;
          for (int n = lane; n < D; n += 64) { float acc = 0.f; for (int k = 0; k < D; ++k) acc += BF(MG[(size_t)row * D + k]) * BF(WoutT[(size_t)n * D + k]); yb[n] = acc; ss += acc * acc; }
          ss = wave_sum(ss); const float rstd = 1.0f / sqrtf(ss * (1.f / 1024.f) + 1e-6f);
          for (int n = lane; n < D; n += 64) { const float e = p.x[(size_t)row * D + n] + yb[n] * rstd * p.post_norm[n]; const float a = p.out[(size_t)row * D + n];
              if (!(fabsf(e - a) <= 0.02f * fabsf(e) + 0.02f)) atomicMax(ctl, 400u); } } }
    xcd_barrier(bar);
    { const float code = (float)__hip_atomic_load(ctl, __ATOMIC_RELAXED, __HIP_MEMORY_SCOPE_AGENT);
      for (size_t i = gt; i < (size_t)M_TOK * D; i += gs) p.out[i] = (i == 0) ? (code == 0.f ? 777.f : code) : 0.f; }
#endif
#undef IN
#undef SEAM
}

constexpr int N_PHASES = 11;
#ifndef MK_ONE_LAUNCH
#define MK_ONE_LAUNCH 1
#endif
extern "C" void kernel_launch(void* const* d_in, const int* in_sizes, int n_in, void* d_out, int out_size, void* d_ws, size_t ws_size, hipStream_t stream) {
    static int grid_blocks = 0;
    if (!grid_blocks) {
        int dev = 0, cus = 0, per_cu = 0;
        (void)hipGetDevice(&dev);
        (void)hipDeviceGetAttribute(&cus, hipDeviceAttributeMultiprocessorCount, dev);
        (void)hipFuncSetAttribute((const void*)fwd_kernel, hipFuncAttributeMaxDynamicSharedMemorySize, LDS_BYTES);
        (void)hipOccupancyMaxActiveBlocksPerMultiprocessor(&per_cu, (const void*)fwd_kernel, 512, LDS_BYTES);
        (void)hipGetLastError();
        grid_blocks = cus > 0 ? cus : 256;
        if (n_in != 17 || out_size != M_TOK * D || ws_size < WS_END) { fprintf(stderr, "kernel_launch: unexpected shapes\n"); }
    }
    (void)hipMemsetAsync((char*)d_ws + WS_BAR, 0, XCD_BAR_WORDS * 4, stream);
    (void)hipMemsetAsync((char*)d_ws + WS_TAB + 32768, 0, 256, stream);
    Params p{};
    p.x = (const float*)d_in[0]; p.mem = (const float*)d_in[1]; p.pre_norm = (const float*)d_in[2]; p.post_norm = (const float*)d_in[3]; p.w_in = (const float*)d_in[4];
    p.lq1 = (const float*)d_in[5]; p.lk1 = (const float*)d_in[6]; p.lq2 = (const float*)d_in[7]; p.lk2 = (const float*)d_in[8]; p.subln = (const float*)d_in[9];
    p.relb = (const float*)d_in[10]; p.lbl = (const float*)d_in[11]; p.hnorm = (const float*)d_in[12]; p.mnorm = (const float*)d_in[13]; p.w_memkv = (const float*)d_in[14];
    p.w_branch = (const float*)d_in[15]; p.w_out = (const float*)d_in[16];
    p.out = (float*)d_out; p.ws = (unsigned char*)d_ws;
#if MK_ONE_LAUNCH
    p.ph_lo = 0; p.ph_hi = N_PHASES;
    { void* args[] = {&p}; hipError_t e = hipLaunchCooperativeKernel((void*)fwd_kernel, dim3(grid_blocks), dim3(512), args, LDS_BYTES, stream);
      if (e != hipSuccess) fprintf(stderr, "cooperative launch failed: %s (grid %d)\n", hipGetErrorString(e), grid_blocks); }
#else
    for (int k = 0; k < N_PHASES; ++k) { p.ph_lo = k; p.ph_hi = k + 1; void* args[] = {&p};
        hipError_t e = hipLaunchCooperativeKernel((void*)fwd_kernel, dim3(grid_blocks), dim3(512), args, LDS_BYTES, stream);
        if (e != hipSuccess) { fprintf(stderr, "launch %d failed: %s\n", k, hipGetErrorString(e)); break; } }
#endif
}
```
